# Optimizing an MI355X kernel written in HIP

```python
import jax, jax.numpy as jnp
from jax import lax
import numpy as np

D_MODEL = 2048
BATCH = 8
SEQ = 2048
DEPTH = 2

POOL_WINDOWS = (2, 4, 8, 16)
POOL_GROUPS = 4
POOL_GROUP_DIM = D_MODEL // 8
POOL_WIDTH = POOL_GROUPS * POOL_GROUP_DIM
MAX_POOL_WINDOW = 16
HEAD_DIM = 64
N_Q_HEADS = D_MODEL // 128
N_KV_HEADS = 4
Q_PER_KV = N_Q_HEADS // N_KV_HEADS
ATTN_WIDTH = N_Q_HEADS * HEAD_DIM
KV_WIDTH = N_KV_HEADS * HEAD_DIM
WINDOW = 128
BLOCK = 128
N_BRANCHES = 2
DEEPNORM_ALPHA = (2 * DEPTH) ** 0.25
DEEPNORM_BETA = (8 * DEPTH) ** -0.25
LN_EPS = 1e-5
OFF_PGATE = POOL_WIDTH
OFF_Q = 2 * POOL_WIDTH
OFF_K = OFF_Q + ATTN_WIDTH
OFF_V = OFF_K + KV_WIDTH
OFF_AGATE = OFF_V + KV_WIDTH
OFF_MERGE = OFF_AGATE + ATTN_WIDTH
N_IN = OFF_MERGE + N_BRANCHES * D_MODEL

kernel_name = "hybrid_pool_swa_sink_gated_deepnorm"


def _layernorm(x, g, b):
    xf = x.astype(jnp.float32)
    mu = jnp.mean(xf, axis=-1, keepdims=True)
    var = jnp.mean(jnp.square(xf - mu), axis=-1, keepdims=True)
    return ((xf - mu) * lax.rsqrt(var + LN_EPS) * g + b).astype(x.dtype)


def _pool_mixer(p, w_grp, scale):
    B, S, _ = p.shape
    cs = jnp.cumsum(p.astype(jnp.float32), axis=1)
    cs = jnp.pad(cs, ((0, 0), (MAX_POOL_WINDOW, 0), (0, 0)))
    pos = jnp.arange(S)
    pooled = []
    for g, w in enumerate(POOL_WINDOWS):
        lo, hi = g * POOL_GROUP_DIM, (g + 1) * POOL_GROUP_DIM
        win_sum = cs[:, MAX_POOL_WINDOW:, lo:hi] - cs[:, MAX_POOL_WINDOW - w:MAX_POOL_WINDOW - w + S, lo:hi]
        count = jnp.minimum(pos + 1, w).astype(jnp.float32)[None, :, None]
        pooled.append(win_sum / count)
    pooled = jnp.concatenate(pooled, axis=-1).astype(p.dtype) - p
    pooled = pooled.reshape(B, S, POOL_GROUPS, POOL_GROUP_DIM)
    mixed = jnp.einsum('bsgc,gcd->bsgd', pooled, w_grp).reshape(B, S, POOL_WIDTH)
    return mixed * scale


def _sliding_window_attention(q, k, v, sinks):
    B, S, _ = q.shape
    nb = S // BLOCK
    qb = q.reshape(B, nb, BLOCK, N_KV_HEADS, Q_PER_KV, HEAD_DIM)
    kb = k.reshape(B, nb, BLOCK, N_KV_HEADS, HEAD_DIM)
    vb = v.reshape(B, nb, BLOCK, N_KV_HEADS, HEAD_DIM)

    def with_prev(t):
        prev = jnp.pad(t[:, :-1], ((0, 0), (1, 0), (0, 0), (0, 0), (0, 0)))
        return jnp.concatenate([prev, t], axis=2)

    kw, vw = with_prev(kb), with_prev(vb)
    scores = jnp.einsum('bnqhgd,bnkhd->bnhgqk', qb, kw).astype(jnp.float32) * (HEAD_DIM ** -0.5)
    qi = jnp.arange(BLOCK)[:, None]
    kj = jnp.arange(2 * BLOCK)[None, :]
    rel = BLOCK + qi - kj
    band = (rel >= 0) & (rel < WINDOW)
    key_pos = jnp.arange(nb)[:, None] * BLOCK - BLOCK + kj
    valid = band[None] & (key_pos >= 0)[:, None, :]
    scores = jnp.where(valid[None, :, None, None], scores, -jnp.inf)
    sink = sinks.astype(jnp.float32).reshape(N_KV_HEADS, Q_PER_KV)[None, None, :, :, None, None]
    m = jnp.maximum(jnp.max(scores, axis=-1, keepdims=True), sink)
    e = jnp.exp(scores - m)
    probs = (e / (jnp.sum(e, axis=-1, keepdims=True) + jnp.exp(sink - m))).astype(v.dtype)
    o = jnp.einsum('bnhgqk,bnkhd->bnqhgd', probs, vw)
    return o.reshape(B, S, ATTN_WIDTH)


def _layer(x, c, w_ada, b_ada, w_in, w_pool_grp, pool_scale, sinks, w_pool_up, w_attn_up, w_out, ln_g, ln_b):
    mod = jax.nn.silu(c) @ w_ada + b_ada
    shift, scale, gate = jnp.split(mod, 3, axis=-1)
    u = x * (1 + scale[:, None, :]) + shift[:, None, :]
    h = u @ w_in
    p_in, p_gate, q, k, v, a_gate, g_merge = jnp.split(
        h, [OFF_PGATE, OFF_Q, OFF_K, OFF_V, OFF_AGATE, OFF_MERGE], axis=-1)
    y_pool = _pool_mixer(p_in, w_pool_grp, pool_scale) * jax.nn.silu(p_gate)
    y_attn = _sliding_window_attention(q, k, v, sinks) * jax.nn.silu(a_gate)
    g_pool, g_attn = jnp.split(jax.nn.sigmoid(g_merge), N_BRANCHES, axis=-1)
    merged = g_pool * (y_pool @ w_pool_up) + g_attn * (y_attn @ w_attn_up)
    out = merged @ w_out
    return _layernorm(DEEPNORM_ALPHA * x + gate[:, None, :] * out, ln_g, ln_b)


def setup_inputs(seed: int = 0) -> dict:
    key = jax.random.key(seed)
    ks = jax.random.split(key, 14)
    D = D_MODEL
    f32 = jnp.float32
    nrm = lambda k, shape, s: jax.random.normal(k, shape, f32) * s
    col_scale = jnp.ones((N_IN,), f32).at[OFF_V:OFF_AGATE].set(DEEPNORM_BETA)
    return {
        "x": nrm(ks[0], (BATCH, SEQ, D), 1.0),
        "c": nrm(ks[1], (BATCH, D), 1.0),
        "w_ada": nrm(ks[2], (DEPTH, D, 3 * D), D ** -0.5),
        "b_ada": nrm(ks[3], (DEPTH, 3 * D), 0.02),
        "w_in": nrm(ks[4], (DEPTH, D, N_IN), D ** -0.5) * col_scale,
        "w_pool_grp": nrm(ks[5], (DEPTH, POOL_GROUPS, POOL_GROUP_DIM, POOL_GROUP_DIM), POOL_GROUP_DIM ** -0.5),
        "pool_scale": 1.0 + nrm(ks[6], (DEPTH, POOL_WIDTH), 0.1),
        "sinks": nrm(ks[7], (DEPTH, N_Q_HEADS), 1.0),
        "w_pool_up": nrm(ks[8], (DEPTH, POOL_WIDTH, D), POOL_WIDTH ** -0.5 * DEEPNORM_BETA),
        "w_attn_up": nrm(ks[9], (DEPTH, ATTN_WIDTH, D), ATTN_WIDTH ** -0.5 * DEEPNORM_BETA),
        "w_out": nrm(ks[10], (DEPTH, D, D), D ** -0.5 * DEEPNORM_BETA),
        "ln_g": 1.0 + nrm(ks[11], (DEPTH, D), 0.05),
        "ln_b": nrm(ks[12], (DEPTH, D), 0.02),
    }


def reference(x, c, w_ada, b_ada, w_in, w_pool_grp, pool_scale, sinks, w_pool_up, w_attn_up, w_out, ln_g, ln_b):
    for l in range(DEPTH):
        x = _layer(x, c, w_ada[l], b_ada[l], w_in[l], w_pool_grp[l], pool_scale[l], sinks[l],
                   w_pool_up[l], w_attn_up[l], w_out[l], ln_g[l], ln_b[l])
    return x
```

```cpp
#include <hip/hip_runtime.h>
#include <hip/hip_cooperative_groups.h>
#include <cstdio>
namespace cg = cooperative_groups;

#ifndef MK_PER_PHASE_LAUNCH
#define MK_PER_PHASE_LAUNCH 0
#endif

#define LAS __attribute__((address_space(3)))
typedef unsigned short bf16_t;
typedef short bf16x8 __attribute__((ext_vector_type(8)));
typedef float f32x4 __attribute__((ext_vector_type(4)));
typedef unsigned u32x4 __attribute__((ext_vector_type(4)));
typedef unsigned u32x2 __attribute__((ext_vector_type(2)));

constexpr int D = 2048, NBATCH = 8, SEQ = 2048, T = NBATCH * SEQ, NIN = 8704, DEPTH = 2;
constexpr int OFF_PGATE = 1024, OFF_Q = 2048, OFF_K = 3072, OFF_V = 3328, OFF_AGATE = 3584, OFF_GP = 4608, OFF_GA = 6656;
constexpr float ALPHA = 1.41421356237f, LN_EPS = 1e-5f, LOG2E = 1.44269504089f;
constexpr int NTHREADS = 512, LDS_BYTES = 131072;

constexpr size_t WS_WIN = 0;
constexpr size_t WS_WCAT = WS_WIN + (size_t)2 * NIN * D * 2;
constexpr size_t WS_WOUT = WS_WCAT + (size_t)2 * D * D * 2;
constexpr size_t WS_WGRP = WS_WOUT + (size_t)2 * D * D * 2;
constexpr size_t WS_MOD = WS_WGRP + (size_t)2 * 4 * 256 * 256 * 2;
constexpr size_t WS_U = WS_MOD + (size_t)2 * 8 * 6144 * 4;
constexpr size_t WS_H = WS_U + (size_t)T * D * 2;
constexpr size_t WS_YCAT = WS_H + (size_t)T * NIN * 2;
constexpr size_t WS_END = WS_YCAT + (size_t)T * D * 2;

__device__ __forceinline__ unsigned cvt_pk_bf16(float lo, float hi) { unsigned r; asm volatile("v_cvt_pk_bf16_f32 %0, %1, %2" : "=v"(r) : "v"(lo), "v"(hi)); return r; }
__device__ __forceinline__ float bf_lo(unsigned w) { return __uint_as_float(w << 16); }
__device__ __forceinline__ float bf_hi(unsigned w) { return __uint_as_float(w & 0xffff0000u); }
__device__ __forceinline__ float fast_sigmoid(float x) { return __builtin_amdgcn_rcpf(1.0f + __builtin_amdgcn_exp2f(-x * LOG2E)); }

constexpr int BM = 256, BK = 64, HALF = 128, HTB = HALF * BK * 2, NXCD = 8, WGM = 8;
__device__ __forceinline__ int lds_byte(int r, int c) { const int st = (r >> 4) * 2 + (c >> 5), rr = r & 15, cc = c & 31, ob = rr * 64 + cc * 2; return st * 1024 + (ob ^ (((ob >> 9) & 1) << 5)); }
__device__ __forceinline__ void stage_rc(int b, int& R, int& C) { const int st = b / 1024, sb = b % 1024, swz = sb ^ (((sb >> 9) & 1) << 5); R = (st >> 1) * 16 + swz / 64; C = (st & 1) * 32 + (swz % 64) / 2; }
__device__ __forceinline__ int perm32(int rho) { const int n = rho >> 4, i = rho & 15; return 8 * (i >> 2) + 4 * n + (i & 3); }

struct Unit { int pm, pn; };
struct Gemm { const bf16_t* A; const bf16_t* Bt; int lda, ldb, K, a_pn_bytes; };
struct StaticOrder {
    int nM, nN, nwg, G, c;
    __device__ void init(int M, int N, int G_, int c_) { nM = M / BM; nN = N / BM; nwg = nM * nN; G = G_; c = c_; }
    __device__ bool next(int i, Unit& u) const {
        const long L = (long)i * G + c; if (L >= nwg) return false;
        int wgid = (int)L; { const int q = nwg / NXCD, r = nwg % NXCD, xcd = wgid % NXCD, off = wgid / NXCD; wgid = (xcd < r ? xcd * (q + 1) : r * (q + 1) + (xcd - r) * q) + off; }
        const int nig = WGM * nN, gid = wgid / nig, fm = gid * WGM, gsz = (nM - fm) < WGM ? (nM - fm) : WGM;
        u.pm = fm + ((wgid % nig) % gsz); u.pn = (wgid % nig) / gsz; return true;
    }
};


struct EpiH {
    static constexpr bool PERM = true, MID = false;
    bf16_t* O;
    __device__ __forceinline__ void mid(f32x4 (&)[2][2][4][2], const Unit&, int, int, int, int) const {}
    __device__ __forceinline__ void operator()(const f32x4 (&acc)[2][2][4][2], const Unit& u, int wr, int wc, int fr, int fq) const {
        const int pn = u.pn;
        const int act = (pn < 4) ? 0 : (pn < 8) ? 1 : (pn < 14) ? 0 : (pn < 18) ? 1 : 2;
        const float sc = (pn >= 8 && pn < 12) ? 0.125f : 1.0f;
        const int row0 = u.pm * BM + wr * 64 + fr, col0 = pn * BM + wc * 32 + 8 * fq;
#pragma unroll
        for (int ai = 0; ai < 2; ++ai)
#pragma unroll
            for (int m = 0; m < 4; ++m) { bf16_t* rowp = O + (size_t)(row0 + ai * HALF + m * 16) * NIN + col0;
#pragma unroll
                for (int bj = 0; bj < 2; ++bj) { f32x4 v0 = acc[ai][bj][m][0], v1 = acc[ai][bj][m][1];
                    if (act == 1) {
#pragma unroll
                        for (int j = 0; j < 4; ++j) { v0[j] = v0[j] * fast_sigmoid(v0[j]); v1[j] = v1[j] * fast_sigmoid(v1[j]); }
                    } else if (act == 2) {
#pragma unroll
                        for (int j = 0; j < 4; ++j) { v0[j] = fast_sigmoid(v0[j]); v1[j] = fast_sigmoid(v1[j]); }
                    } else { v0 = v0 * sc; v1 = v1 * sc; }
                    u32x4 w; w.x = cvt_pk_bf16(v0[0], v0[1]); w.y = cvt_pk_bf16(v0[2], v0[3]); w.z = cvt_pk_bf16(v1[0], v1[1]); w.w = cvt_pk_bf16(v1[2], v1[3]);
                    *(u32x4*)(rowp + bj * HALF) = w; } }
    }
};
struct EpiPool {
    static constexpr bool PERM = true, MID = false;
    const bf16_t* H; const float* pscale; bf16_t* Y;
    __device__ __forceinline__ void mid(f32x4 (&)[2][2][4][2], const Unit&, int, int, int, int) const {}
    __device__ __forceinline__ void operator()(const f32x4 (&acc)[2][2][4][2], const Unit& u, int wr, int wc, int fr, int fq) const {
        const int row0 = u.pm * BM + wr * 64 + fr, col0 = u.pn * BM + wc * 32 + 8 * fq;
        f32x4 ps[2][2];
#pragma unroll
        for (int bj = 0; bj < 2; ++bj) { ps[bj][0] = *(const f32x4*)(pscale + col0 + bj * HALF); ps[bj][1] = *(const f32x4*)(pscale + col0 + bj * HALF + 4); }
#pragma unroll
        for (int ai = 0; ai < 2; ++ai)
#pragma unroll
            for (int m = 0; m < 4; ++m) { const size_t r = (size_t)(row0 + ai * HALF + m * 16);
#pragma unroll
                for (int bj = 0; bj < 2; ++bj) {
                    const u32x4 g = *(const u32x4*)(H + r * NIN + OFF_PGATE + col0 + bj * HALF);
                    const f32x4 v0 = acc[ai][bj][m][0] * ps[bj][0], v1 = acc[ai][bj][m][1] * ps[bj][1];
                    u32x4 w; w.x = cvt_pk_bf16(v0[0] * bf_lo(g.x), v0[1] * bf_hi(g.x)); w.y = cvt_pk_bf16(v0[2] * bf_lo(g.y), v0[3] * bf_hi(g.y));
                    w.z = cvt_pk_bf16(v1[0] * bf_lo(g.z), v1[1] * bf_hi(g.z)); w.w = cvt_pk_bf16(v1[2] * bf_lo(g.w), v1[3] * bf_hi(g.w));
                    *(u32x4*)(Y + r * D + col0 + bj * HALF) = w; }
                asm volatile("" ::: "memory"); }
    }
};
struct EpiMerge {
    static constexpr bool PERM = true, MID = true;
    const bf16_t* H; bf16_t* O;
    __device__ __forceinline__ void mid(f32x4 (&acc)[2][2][4][2], const Unit& u, int wr, int wc, int fr, int fq) const {
        int row0 = u.pm * BM + wr * 64 + fr, col0 = u.pn * BM + wc * 32 + 8 * fq;
        asm volatile("" : "+v"(row0), "+v"(col0));
#pragma unroll
        for (int ai = 0; ai < 2; ++ai)
#pragma unroll
            for (int m = 0; m < 4; ++m) { const bf16_t* hp = H + (size_t)(row0 + ai * HALF + m * 16) * NIN + col0;
#pragma unroll
                for (int bj = 0; bj < 2; ++bj) {
                    const u32x4 gp = *(const u32x4*)(hp + OFF_GP + bj * HALF), ga = *(const u32x4*)(hp + OFF_GA + bj * HALF);
                    f32x4 r0, r1;
                    r0[0] = bf_lo(gp.x) * __builtin_amdgcn_rcpf(fmaxf(bf_lo(ga.x), 1e-30f)); r0[1] = bf_hi(gp.x) * __builtin_amdgcn_rcpf(fmaxf(bf_hi(ga.x), 1e-30f));
                    r0[2] = bf_lo(gp.y) * __builtin_amdgcn_rcpf(fmaxf(bf_lo(ga.y), 1e-30f)); r0[3] = bf_hi(gp.y) * __builtin_amdgcn_rcpf(fmaxf(bf_hi(ga.y), 1e-30f));
                    r1[0] = bf_lo(gp.z) * __builtin_amdgcn_rcpf(fmaxf(bf_lo(ga.z), 1e-30f)); r1[1] = bf_hi(gp.z) * __builtin_amdgcn_rcpf(fmaxf(bf_hi(ga.z), 1e-30f));
                    r1[2] = bf_lo(gp.w) * __builtin_amdgcn_rcpf(fmaxf(bf_lo(ga.w), 1e-30f)); r1[3] = bf_hi(gp.w) * __builtin_amdgcn_rcpf(fmaxf(bf_hi(ga.w), 1e-30f));
                    acc[ai][bj][m][0] = acc[ai][bj][m][0] * r0; acc[ai][bj][m][1] = acc[ai][bj][m][1] * r1; }
                asm volatile("" ::: "memory"); }
    }
    __device__ __forceinline__ void operator()(const f32x4 (&acc)[2][2][4][2], const Unit& u, int wr, int wc, int fr, int fq) const {
        const int row0 = u.pm * BM + wr * 64 + fr, col0 = u.pn * BM + wc * 32 + 8 * fq;
#pragma unroll
        for (int ai = 0; ai < 2; ++ai)
#pragma unroll
            for (int m = 0; m < 4; ++m) { const size_t r = (size_t)(row0 + ai * HALF + m * 16);
#pragma unroll
                for (int bj = 0; bj < 2; ++bj) {
                    const u32x4 ga = *(const u32x4*)(H + r * NIN + OFF_GA + col0 + bj * HALF);
                    const f32x4 v0 = acc[ai][bj][m][0], v1 = acc[ai][bj][m][1];
                    u32x4 w; w.x = cvt_pk_bf16(v0[0] * bf_lo(ga.x), v0[1] * bf_hi(ga.x)); w.y = cvt_pk_bf16(v0[2] * bf_lo(ga.y), v0[3] * bf_hi(ga.y));
                    w.z = cvt_pk_bf16(v1[0] * bf_lo(ga.z), v1[1] * bf_hi(ga.z)); w.w = cvt_pk_bf16(v1[2] * bf_lo(ga.w), v1[3] * bf_hi(ga.w));
                    *(u32x4*)(O + r * D + col0 + bj * HALF) = w; }
                asm volatile("" ::: "memory"); }
    }
};
struct EpiZ {
    static constexpr bool PERM = false, MID = false;
    const float* X; const float* gate; float* Z;
    __device__ __forceinline__ void mid(f32x4 (&)[2][2][4][2], const Unit&, int, int, int, int) const {}
    __device__ __forceinline__ void operator()(const f32x4 (&acc)[2][2][4][2], const Unit& u, int wr, int wc, int fr, int fq) const {
        const int row0 = u.pm * BM + wr * 64 + fr, col0 = u.pn * BM + wc * 32 + 4 * fq;
        const float* gp = gate + (size_t)(u.pm >> 3) * 6144 + col0;
        f32x4 gv[2][2];
#pragma unroll
        for (int bj = 0; bj < 2; ++bj)
#pragma unroll
            for (int n = 0; n < 2; ++n) gv[bj][n] = *(const f32x4*)(gp + bj * HALF + n * 16);
#pragma unroll
        for (int ai = 0; ai < 2; ++ai)
#pragma unroll
            for (int m = 0; m < 4; ++m) { const size_t off = (size_t)(row0 + ai * HALF + m * 16) * D + col0;
#pragma unroll
                for (int bj = 0; bj < 2; ++bj)
#pragma unroll
                    for (int n = 0; n < 2; ++n) { const f32x4 xv = *(const f32x4*)(X + off + bj * HALF + n * 16);
                        *(f32x4*)(Z + off + bj * HALF + n * 16) = xv * ALPHA + gv[bj][n] * acc[ai][bj][m][n]; } }
    }
};

template <class Epi>
__device__ __forceinline__ void gemm_phase(LAS unsigned char* lds, const Gemm g, const StaticOrder& S, const Epi& E) {
    int tid = threadIdx.x; asm volatile("" : "+v"(tid));
    const int wid = __builtin_amdgcn_readfirstlane(tid >> 6), lane = tid & 63, wr = wid >> 2, wc = wid & 3, fr = lane & 15, fq = lane >> 4;
    int Kv = g.K; asm volatile("" : "+s"(Kv));
    const int nt = Kv / BK;
    unsigned voffA[2], voffB[2];
#pragma unroll
    for (int i = 0; i < 2; ++i) { int R, C; stage_rc(tid * 16 + i * 8192, R, C); const int Rb = Epi::PERM ? ((R & ~31) + perm32(R & 31)) : R;
        voffA[i] = (unsigned)(R * g.lda + C) * 2u; voffB[i] = (unsigned)(Rb * g.ldb + C) * 2u; }
    const size_t kstep = (size_t)(BK * 2);
    const size_t hstepA = (size_t)HALF * g.lda * 2, hstepB = (size_t)HALF * g.ldb * 2;
    const size_t tstepA = 2 * hstepA, tstepB = 2 * hstepB;
    const unsigned ldsw = (unsigned)wid * 1024u;
    const int aoff = lds_byte(wr * 64 + fr, fq * 8), boff = lds_byte(wc * 32 + fr, fq * 8);
#define PG8_SA(b, h) (((b) * 2 + (h)) * HTB)
#define PG8_SB(b, h) ((4 + (b) * 2 + (h)) * HTB)
#define PG8_STAGE(bufoff, gbase, voff) do { _Pragma("unroll") for (int _i = 0; _i < 2; ++_i) \
        __builtin_amdgcn_global_load_lds((const unsigned*)((const char*)(gbase) + (voff)[_i]), (LAS unsigned*)(lds + (bufoff) + ldsw + _i * 8192), 16, 0, 0); } while (0)
#define PG8_LDA(dst, b, h) do { _Pragma("unroll") for (int m = 0; m < 4; ++m) _Pragma("unroll") for (int k = 0; k < 2; ++k) dst[m][k] = *(const LAS bf16x8*)(lds + PG8_SA(b, h) + aoff + m * 2048 + k * 1024); } while (0)
#define PG8_LDB(dst, b, h) do { _Pragma("unroll") for (int n = 0; n < 2; ++n) _Pragma("unroll") for (int k = 0; k < 2; ++k) dst[n][k] = *(const LAS bf16x8*)(lds + PG8_SB(b, h) + boff + n * 2048 + k * 1024); } while (0)
#define PG8_MMA(ai, bj, At, Bt) do { __builtin_amdgcn_s_setprio(1); _Pragma("unroll") for (int m = 0; m < 4; ++m) _Pragma("unroll") for (int n = 0; n < 2; ++n) _Pragma("unroll") for (int k = 0; k < 2; ++k) \
        acc[ai][bj][m][n] = __builtin_amdgcn_mfma_f32_16x16x32_bf16(Bt[n][k], At[m][k], acc[ai][bj][m][n], 0, 0, 0); __builtin_amdgcn_s_setprio(0); } while (0)
#define PG8_WAIT_V(n) asm volatile("s_waitcnt vmcnt(" #n ")" ::: "memory")
#define PG8_WAIT_L(n) asm volatile("s_waitcnt lgkmcnt(" #n ")" ::: "memory")
#define PG8_BAR __builtin_amdgcn_s_barrier()
#define PG8_SCHED __builtin_amdgcn_sched_barrier(0)
    Unit cur, nxt; int ui = 0;
    if (!S.next(0, cur)) return;
    f32x4 acc[2][2][4][2];
#pragma unroll
    for (int a = 0; a < 2; ++a)
#pragma unroll
        for (int b = 0; b < 2; ++b)
#pragma unroll
            for (int m = 0; m < 4; ++m)
#pragma unroll
                for (int n = 0; n < 2; ++n) acc[a][b][m][n] = (f32x4){0.f, 0.f, 0.f, 0.f};
    bf16x8 At[4][2], B0[2][2], B1[2][2];
    const char* cA = (const char*)g.A + (size_t)cur.pm * tstepA + (size_t)cur.pn * g.a_pn_bytes; const char* cB = (const char*)g.Bt + (size_t)cur.pn * tstepB;
    PG8_STAGE(PG8_SB(0, 0), cB, voffB); PG8_STAGE(PG8_SA(0, 0), cA, voffA); PG8_STAGE(PG8_SB(0, 1), cB + hstepB, voffB); PG8_STAGE(PG8_SA(0, 1), cA + hstepA, voffA);
    if (wr == 1) PG8_BAR;
    PG8_WAIT_V(4); PG8_BAR;
    PG8_STAGE(PG8_SB(1, 0), cB + kstep, voffB); PG8_STAGE(PG8_SA(1, 0), cA + kstep, voffA); PG8_STAGE(PG8_SB(1, 1), cB + hstepB + kstep, voffB);
    PG8_WAIT_V(6); PG8_BAR;
    for (;;) {
        const bool has_next = S.next(ui + 1, nxt);
        const char* nA = has_next ? (const char*)g.A + (size_t)nxt.pm * tstepA + (size_t)nxt.pn * g.a_pn_bytes : cA; const char* nB = has_next ? (const char*)g.Bt + (size_t)nxt.pn * tstepB : cB;
        for (int t = 0; t < nt; t += 2) {
            const bool last = (t == nt - 2);
            const char* a1 = cA + (size_t)(t + 1) * kstep;
            const char* a2 = last ? nA : cA + (size_t)(t + 2) * kstep; const char* b2 = last ? nB : cB + (size_t)(t + 2) * kstep;
            const char* a3 = a2 + kstep; const char* b3 = b2 + kstep;
            if constexpr (Epi::MID) { if (t == (nt >> 1)) E.mid(acc, cur, wr, wc, fr, fq); }
            PG8_LDB(B0, 0, 0); PG8_SCHED; PG8_LDA(At, 0, 0); PG8_STAGE(PG8_SA(1, 1), a1 + hstepA, voffA);
            PG8_WAIT_L(8); PG8_BAR; PG8_WAIT_L(0); PG8_MMA(0, 0, At, B0); PG8_BAR; PG8_SCHED;
            PG8_LDB(B1, 0, 1); PG8_STAGE(PG8_SB(0, 0), b2, voffB);
            PG8_BAR; PG8_WAIT_L(0); PG8_MMA(0, 1, At, B1); PG8_BAR;
            PG8_LDA(At, 0, 1); PG8_STAGE(PG8_SA(0, 0), a2, voffA);
            PG8_BAR; PG8_WAIT_L(0); PG8_MMA(1, 0, At, B0); PG8_BAR; PG8_SCHED;
            PG8_STAGE(PG8_SB(0, 1), b2 + hstepB, voffB);
            PG8_WAIT_V(6); PG8_BAR; PG8_MMA(1, 1, At, B1); PG8_BAR;
            PG8_LDB(B0, 1, 0); PG8_SCHED; PG8_LDA(At, 1, 0); PG8_STAGE(PG8_SA(0, 1), a2 + hstepA, voffA);
            PG8_WAIT_L(8); PG8_BAR; PG8_WAIT_L(0); PG8_MMA(0, 0, At, B0); PG8_BAR; PG8_SCHED;
            PG8_LDB(B1, 1, 1); PG8_STAGE(PG8_SB(1, 0), b3, voffB);
            PG8_BAR; PG8_WAIT_L(0); PG8_MMA(0, 1, At, B1); PG8_BAR;
            PG8_LDA(At, 1, 1); PG8_STAGE(PG8_SA(1, 0), a3, voffA);
            PG8_BAR; PG8_WAIT_L(0); PG8_MMA(1, 0, At, B0); PG8_BAR; PG8_SCHED;
            PG8_STAGE(PG8_SB(1, 1), b3 + hstepB, voffB);
            PG8_WAIT_V(6); PG8_BAR; PG8_MMA(1, 1, At, B1); PG8_BAR;
        }
        E(acc, cur, wr, wc, fr, fq);
        if (!has_next) break;
#pragma unroll
        for (int a = 0; a < 2; ++a)
#pragma unroll
            for (int b = 0; b < 2; ++b)
#pragma unroll
                for (int m = 0; m < 4; ++m)
#pragma unroll
                    for (int n = 0; n < 2; ++n) acc[a][b][m][n] = (f32x4){0.f, 0.f, 0.f, 0.f};
        cur = nxt; cA = nA; cB = nB; ++ui;
    }
    PG8_WAIT_V(0);
    if (wr == 0) PG8_BAR;
    PG8_BAR;
#undef PG8_SA
#undef PG8_SB
#undef PG8_STAGE
#undef PG8_LDA
#undef PG8_LDB
#undef PG8_MMA
#undef PG8_WAIT_V
#undef PG8_WAIT_L
#undef PG8_BAR
#undef PG8_SCHED
}

struct Args {
    const float* x; const float* c; const float* w_ada; const float* b_ada; const float* w_in; const float* w_pool_grp; const float* pool_scale;
    const float* sinks; const float* w_pool_up; const float* w_attn_up; const float* w_out; const float* ln_g; const float* ln_b;
    float* out; unsigned char* ws; int ph_lo, ph_hi;
};

__device__ void mod_item(LAS unsigned char* lds, const Args& a, int it) {
    const int tid = threadIdx.x;
    LAS float* sc = (LAS float*)lds;
    LAS float* red = (LAS float*)(lds + 65536);
    for (int i = tid; i < NBATCH * D; i += NTHREADS) { const float v = a.c[i]; sc[i] = v * fast_sigmoid(v); }
    __syncthreads();
    const int cq = tid & 15, ks = tid >> 4, l = it / 96, chunk = it % 96, col0 = chunk * 64 + cq * 4;
    const float* W = a.w_ada + (size_t)l * D * 6144 + col0;
    f32x4 acc[8];
#pragma unroll
    for (int b = 0; b < 8; ++b) acc[b] = (f32x4){0.f, 0.f, 0.f, 0.f};
#pragma unroll 4
    for (int k = ks; k < D; k += 32) { const f32x4 w = *(const f32x4*)(W + (size_t)k * 6144);
#pragma unroll
        for (int b = 0; b < 8; ++b) acc[b] += w * sc[b * D + k]; }
#pragma unroll
    for (int b = 0; b < 8; ++b) *(LAS f32x4*)(red + (ks * 8 + b) * 64 + cq * 4) = acc[b];
    __syncthreads();
    { const int b = tid >> 6, col = tid & 63; float s = 0.f;
#pragma unroll 8
      for (int k = 0; k < 32; ++k) s += red[(k * 8 + b) * 64 + col];
      float* mod = (float*)(a.ws + WS_MOD);
      mod[((size_t)l * 8 + b) * 6144 + chunk * 64 + col] = s + a.b_ada[(size_t)l * 6144 + chunk * 64 + col]; }
    __syncthreads();
}

__device__ void wt_tile(LAS unsigned char* lds, const float* src, int lds_src, bf16_t* dst, int ld_dst, int k0, int n0) {
    const int tid = threadIdx.x;
    LAS unsigned* tile = (LAS unsigned*)lds;
    const int c4 = tid & 15, r = tid >> 4;
#pragma unroll
    for (int j = 0; j < 2; ++j) { const int kp = r + 32 * j;
        const f32x4 v0 = *(const f32x4*)(src + (size_t)(k0 + 2 * kp) * lds_src + n0 + 4 * c4);
        const f32x4 v1 = *(const f32x4*)(src + (size_t)(k0 + 2 * kp + 1) * lds_src + n0 + 4 * c4);
#pragma unroll
        for (int e = 0; e < 4; ++e) tile[(4 * c4 + e) * 65 + kp] = cvt_pk_bf16(v0[e], v1[e]); }
    __syncthreads();
    const int w = tid >> 6, lane = tid & 63;
#pragma unroll
    for (int n = w; n < 64; n += 8) *(unsigned*)(dst + (size_t)(n0 + n) * ld_dst + k0 + 2 * lane) = tile[n * 65 + lane];
    __syncthreads();
}
__device__ void weights_phase(LAS unsigned char* lds, const Args& a) {
    constexpr int PER_LAYER = 3232;
    for (int id = blockIdx.x; id < 2 * PER_LAYER; id += gridDim.x) {
        const int l = id / PER_LAYER; int t = id % PER_LAYER;
        const float* src; int ls; bf16_t* dst; int ld; int k0, n0;
        if (t < 2176) { src = a.w_in + (size_t)l * D * NIN; ls = NIN; dst = (bf16_t*)(a.ws + WS_WIN) + (size_t)l * NIN * D; ld = D; n0 = (t % 136) * 64; k0 = (t / 136) * 128; }
        else if (t < 2176 + 256) { t -= 2176; src = a.w_pool_up + (size_t)l * 1024 * D; ls = D; dst = (bf16_t*)(a.ws + WS_WCAT) + (size_t)l * D * D; ld = D; n0 = (t % 32) * 64; k0 = (t / 32) * 128; }
        else if (t < 2176 + 512) { t -= 2176 + 256; src = a.w_attn_up + (size_t)l * 1024 * D; ls = D; dst = (bf16_t*)(a.ws + WS_WCAT) + (size_t)l * D * D + 1024; ld = D; n0 = (t % 32) * 64; k0 = (t / 32) * 128; }
        else if (t < 2176 + 1024) { t -= 2176 + 512; src = a.w_out + (size_t)l * D * D; ls = D; dst = (bf16_t*)(a.ws + WS_WOUT) + (size_t)l * D * D; ld = D; n0 = (t % 32) * 64; k0 = (t / 32) * 128; }
        else { t -= 2176 + 1024; const int g = t >> 3; t &= 7; src = a.w_pool_grp + ((size_t)l * 4 + g) * 65536; ls = 256; dst = (bf16_t*)(a.ws + WS_WGRP) + ((size_t)l * 4 + g) * 65536; ld = 256; n0 = (t & 3) * 64; k0 = (t >> 2) * 128; }
        wt_tile(lds, src, ls, dst, ld, k0, n0);
    }
}

__device__ void uprep_phase(const Args& a) {
    const float* mod = (const float*)(a.ws + WS_MOD);
    bf16_t* U = (bf16_t*)(a.ws + WS_U);
    for (size_t i = (size_t)blockIdx.x * NTHREADS + threadIdx.x; i < (size_t)T * D / 8; i += (size_t)gridDim.x * NTHREADS) {
        const size_t row = i >> 8; const int c8 = (int)(i & 255) * 8; const int b = (int)(row >> 11);
        const f32x4 x0 = *(const f32x4*)(a.x + row * D + c8), x1 = *(const f32x4*)(a.x + row * D + c8 + 4);
        const float* mp = mod + (size_t)b * 6144 + c8;
        const f32x4 sh0 = *(const f32x4*)(mp), sh1 = *(const f32x4*)(mp + 4), s0 = *(const f32x4*)(mp + 2048), s1 = *(const f32x4*)(mp + 2052);
        const f32x4 u0 = x0 * (s0 + 1.0f) + sh0, u1 = x1 * (s1 + 1.0f) + sh1;
        u32x4 w; w.x = cvt_pk_bf16(u0[0], u0[1]); w.y = cvt_pk_bf16(u0[2], u0[3]); w.z = cvt_pk_bf16(u1[0], u1[1]); w.w = cvt_pk_bf16(u1[2], u1[3]);
        *(u32x4*)(U + row * D + c8) = w;
    }
}

__device__ void attn_item(LAS unsigned char* lds, const bf16_t* H, bf16_t* Y, const float* sinks, int it) {
    int tid = threadIdx.x; asm volatile("" : "+v"(tid));
    const int lane = tid & 63, wave = __builtin_amdgcn_readfirstlane(tid >> 6), ln = lane & 15, g = lane >> 4;
    const int b = it >> 6, nb = (it >> 2) & 15, kvh = it & 3;
    LAS bf16_t* Ks = (LAS bf16_t*)lds;
    LAS bf16_t* Vt = (LAS bf16_t*)(lds + 36864);
#pragma unroll
    for (int j = 0; j < 4; ++j) {
        const int idx = tid + NTHREADS * j, key = idx >> 3, ch = idx & 7, s = nb * 128 - 128 + key;
        u32x4 kv = (u32x4){0u, 0u, 0u, 0u}, vv = (u32x4){0u, 0u, 0u, 0u};
        if (s >= 0) { const bf16_t* rp = H + ((size_t)b * SEQ + s) * NIN + kvh * 64 + ch * 8; kv = *(const u32x4*)(rp + OFF_K); vv = *(const u32x4*)(rp + OFF_V); }
        *(LAS u32x4*)(Ks + key * 72 + ch * 8) = kv;
        const int kk = key & 31, pos = (key & ~31) + ((kk & 15) >> 2) * 8 + (kk >> 4) * 4 + (kk & 3);
        const unsigned vw[4] = {vv.x, vv.y, vv.z, vv.w};
#pragma unroll
        for (int e = 0; e < 8; ++e) { const int d = ch * 8 + e, slot = 16 * ((d >> 2) & 3) + 4 * (d >> 4) + (d & 3);
            Vt[slot * 264 + pos] = (bf16_t)((e & 1) ? (vw[e >> 1] >> 16) : (vw[e >> 1] & 0xffffu)); }
    }
    __syncthreads();
    for (int tk = wave; tk < 16; tk += 8) {
        const int qsub = tk & 3, head = tk >> 2, hq = kvh * 4 + head, r0 = qsub * 32;
        const size_t qrow0 = (size_t)b * SEQ + nb * 128 + r0;
        bf16x8 qf[2][2];
#pragma unroll
        for (int qt = 0; qt < 2; ++qt)
#pragma unroll
            for (int kk = 0; kk < 2; ++kk) qf[qt][kk] = *(const bf16x8*)(H + (qrow0 + 16 * qt + ln) * NIN + OFF_Q + hq * 64 + 32 * kk + 8 * g);
        f32x4 s[10][2];
#pragma unroll
        for (int kt = 0; kt < 10; ++kt) { s[kt][0] = (f32x4){0.f, 0.f, 0.f, 0.f}; s[kt][1] = (f32x4){0.f, 0.f, 0.f, 0.f}; }
#pragma unroll
        for (int kt = 0; kt < 10; ++kt)
#pragma unroll
            for (int kk = 0; kk < 2; ++kk) { const bf16x8 kf = *(const LAS bf16x8*)(Ks + (r0 + 16 * kt + ln) * 72 + 32 * kk + 8 * g);
                s[kt][0] = __builtin_amdgcn_mfma_f32_16x16x32_bf16(kf, qf[0][kk], s[kt][0], 0, 0, 0);
                s[kt][1] = __builtin_amdgcn_mfma_f32_16x16x32_bf16(kf, qf[1][kk], s[kt][1], 0, 0, 0); }
        const float sink = sinks[hq];
        const int kmin = (nb == 0) ? 128 : 0;
        float inv[2], mx[2];
#pragma unroll
        for (int qt = 0; qt < 2; ++qt) {
            const int qr = 16 * qt + ln; float m = -INFINITY;
#pragma unroll
            for (int kt = 0; kt < 10; ++kt)
#pragma unroll
                for (int e = 0; e < 4; ++e) { const int kr = 16 * kt + 4 * g + e; const bool valid = (kr > qr) && (kr <= qr + 128) && (r0 + kr >= kmin);
                    const float v = valid ? s[kt][qt][e] : -INFINITY; s[kt][qt][e] = v; m = fmaxf(m, v); }
            m = fmaxf(m, __shfl_xor(m, 16)); m = fmaxf(m, __shfl_xor(m, 32)); m = fmaxf(m, sink);
            float sum = 0.f;
#pragma unroll
            for (int kt = 0; kt < 10; ++kt)
#pragma unroll
                for (int e = 0; e < 4; ++e) { const float p = __builtin_amdgcn_exp2f((s[kt][qt][e] - m) * LOG2E); s[kt][qt][e] = p; sum += p; }
            sum += __shfl_xor(sum, 16); sum += __shfl_xor(sum, 32);
            sum += __builtin_amdgcn_exp2f((sink - m) * LOG2E);
            inv[qt] = 1.0f / sum; mx[qt] = m;
        }
        f32x4 o[4][2];
#pragma unroll
        for (int dt = 0; dt < 4; ++dt) { o[dt][0] = (f32x4){0.f, 0.f, 0.f, 0.f}; o[dt][1] = (f32x4){0.f, 0.f, 0.f, 0.f}; }
#pragma unroll
        for (int pp = 0; pp < 5; ++pp) {
            bf16x8 pf[2];
#pragma unroll
            for (int qt = 0; qt < 2; ++qt) { const f32x4 p0 = s[2 * pp][qt] * inv[qt], p1 = s[2 * pp + 1][qt] * inv[qt];
                u32x4 w; w.x = cvt_pk_bf16(p0[0], p0[1]); w.y = cvt_pk_bf16(p0[2], p0[3]); w.z = cvt_pk_bf16(p1[0], p1[1]); w.w = cvt_pk_bf16(p1[2], p1[3]);
                pf[qt] = __builtin_bit_cast(bf16x8, w); }
#pragma unroll
            for (int dt = 0; dt < 4; ++dt) { const bf16x8 vf = *(const LAS bf16x8*)(Vt + (16 * dt + ln) * 264 + r0 + 32 * pp + 8 * g);
                o[dt][0] = __builtin_amdgcn_mfma_f32_16x16x32_bf16(vf, pf[0], o[dt][0], 0, 0, 0);
                o[dt][1] = __builtin_amdgcn_mfma_f32_16x16x32_bf16(vf, pf[1], o[dt][1], 0, 0, 0); }
        }
        (void)mx;
#pragma unroll
        for (int qt = 0; qt < 2; ++qt) { const size_t row = qrow0 + 16 * qt + ln;
            const bf16_t* gp = H + row * NIN + OFF_AGATE + hq * 64 + 16 * g;
            const u32x4 g0 = *(const u32x4*)gp, g1 = *(const u32x4*)(gp + 8);
            u32x4 w0, w1;
            w0.x = cvt_pk_bf16(o[0][qt][0] * bf_lo(g0.x), o[0][qt][1] * bf_hi(g0.x)); w0.y = cvt_pk_bf16(o[0][qt][2] * bf_lo(g0.y), o[0][qt][3] * bf_hi(g0.y));
            w0.z = cvt_pk_bf16(o[1][qt][0] * bf_lo(g0.z), o[1][qt][1] * bf_hi(g0.z)); w0.w = cvt_pk_bf16(o[1][qt][2] * bf_lo(g0.w), o[1][qt][3] * bf_hi(g0.w));
            w1.x = cvt_pk_bf16(o[2][qt][0] * bf_lo(g1.x), o[2][qt][1] * bf_hi(g1.x)); w1.y = cvt_pk_bf16(o[2][qt][2] * bf_lo(g1.y), o[2][qt][3] * bf_hi(g1.y));
            w1.z = cvt_pk_bf16(o[3][qt][0] * bf_lo(g1.z), o[3][qt][1] * bf_hi(g1.z)); w1.w = cvt_pk_bf16(o[3][qt][2] * bf_lo(g1.w), o[3][qt][3] * bf_hi(g1.w));
            bf16_t* yp = Y + row * D + 1024 + hq * 64 + 16 * g;
            *(u32x4*)yp = w0; *(u32x4*)(yp + 8) = w1; }
    }
    __syncthreads();
}

__device__ void pool_build(const bf16_t* H, bf16_t* P, int gidx) {
    const int lane = gidx & 63, wv = gidx >> 6;
    const int grp = wv & 3, rp = wv >> 2;
    const int run = rp * 2 + (lane >> 5), c8 = grp * 32 + (lane & 31);
    const int w = 2 << grp, t0 = run * 16, pos0 = t0 & (SEQ - 1);
    const bf16_t* hp = H + (size_t)t0 * NIN + c8 * 8;
    float sum[8];
#pragma unroll
    for (int e = 0; e < 8; ++e) sum[e] = 0.f;
    for (int j = 1; j < w; ++j) if (pos0 - j >= 0) { const u32x4 v = *(const u32x4*)(hp - (size_t)j * NIN);
        sum[0] += bf_lo(v.x); sum[1] += bf_hi(v.x); sum[2] += bf_lo(v.y); sum[3] += bf_hi(v.y); sum[4] += bf_lo(v.z); sum[5] += bf_hi(v.z); sum[6] += bf_lo(v.w); sum[7] += bf_hi(v.w); }
    for (int i = 0; i < 16; ++i) {
        const u32x4 v = *(const u32x4*)(hp + (size_t)i * NIN);
        const float cur[8] = {bf_lo(v.x), bf_hi(v.x), bf_lo(v.y), bf_hi(v.y), bf_lo(v.z), bf_hi(v.z), bf_lo(v.w), bf_hi(v.w)};
        const int cnt = min(pos0 + i + 1, w); const float rc = 1.0f / (float)cnt;
        float o[8];
#pragma unroll
        for (int e = 0; e < 8; ++e) { sum[e] += cur[e]; o[e] = sum[e] * rc - cur[e]; }
        u32x4 wv4; wv4.x = cvt_pk_bf16(o[0], o[1]); wv4.y = cvt_pk_bf16(o[2], o[3]); wv4.z = cvt_pk_bf16(o[4], o[5]); wv4.w = cvt_pk_bf16(o[6], o[7]);
        *(u32x4*)(P + (size_t)(t0 + i) * 1024 + c8 * 8) = wv4;
        if (pos0 + i - (w - 1) >= 0) { const u32x4 q = *(const u32x4*)(hp + (ptrdiff_t)(i - (w - 1)) * NIN);
            sum[0] -= bf_lo(q.x); sum[1] -= bf_hi(q.x); sum[2] -= bf_lo(q.y); sum[3] -= bf_hi(q.y); sum[4] -= bf_lo(q.z); sum[5] -= bf_hi(q.z); sum[6] -= bf_lo(q.w); sum[7] -= bf_hi(q.w); }
    }
}

__device__ void ln_phase(const float* Z, const float* lg, const float* lb, float* xout, const float* modn, bf16_t* U) {
    const int lane = threadIdx.x & 63, wave = threadIdx.x >> 6;
    for (int row = blockIdx.x * 8 + wave; row < T; row += gridDim.x * 8) {
        const float* zp = Z + (size_t)row * D + lane * 4;
        f32x4 v[8]; float s = 0.f;
#pragma unroll
        for (int j = 0; j < 8; ++j) { v[j] = *(const f32x4*)(zp + j * 256); s += (v[j][0] + v[j][1]) + (v[j][2] + v[j][3]); }
#pragma unroll
        for (int o = 1; o < 64; o <<= 1) s += __shfl_xor(s, o);
        const float mean = s * (1.0f / D); float q = 0.f;
#pragma unroll
        for (int j = 0; j < 8; ++j) { const f32x4 d = v[j] - mean; q += (d[0] * d[0] + d[1] * d[1]) + (d[2] * d[2] + d[3] * d[3]); }
#pragma unroll
        for (int o = 1; o < 64; o <<= 1) q += __shfl_xor(q, o);
        const float rstd = 1.0f / sqrtf(q * (1.0f / D) + LN_EPS);
        const int b = row >> 11;
#pragma unroll
        for (int j = 0; j < 8; ++j) { const int col = lane * 4 + j * 256;
            const f32x4 gg = *(const f32x4*)(lg + col), bb = *(const f32x4*)(lb + col);
            const f32x4 y = (v[j] - mean) * rstd * gg + bb;
            *(f32x4*)(xout + (size_t)row * D + col) = y;
            if (U) { const float* mp = modn + (size_t)b * 6144 + col; const f32x4 sh = *(const f32x4*)mp, sc = *(const f32x4*)(mp + 2048);
                const f32x4 u = y * (sc + 1.0f) + sh; u32x2 w; w.x = cvt_pk_bf16(u[0], u[1]); w.y = cvt_pk_bf16(u[2], u[3]);
                *(u32x2*)(U + (size_t)row * D + col) = w; } }
    }
}

constexpr int N_PHASES = 2 + 6 * DEPTH;
__global__ void __launch_bounds__(NTHREADS, 2) fwd_megakernel(Args a) {
    extern __shared__ __attribute__((aligned(16))) unsigned char lds_raw[];
    LAS unsigned char* lds = (LAS unsigned char*)lds_raw;
    cg::grid_group grid = cg::this_grid();
    const int lo = a.ph_lo, hi = a.ph_hi;
#ifndef PH_MASK
#define PH_MASK 0xff
#endif
#define IN(k) (lo <= (k) && (k) < hi)
#define EN(i) ((PH_MASK >> (i)) & 1)
#define SEAM(k) do { if ((k) + 1 < hi) grid.sync(); } while (0)
    unsigned char* ws = a.ws;
    bf16_t* Hb = (bf16_t*)(ws + WS_H); float* Zb = (float*)(ws + WS_H);
    bf16_t* Ub = (bf16_t*)(ws + WS_U); bf16_t* Pb = (bf16_t*)(ws + WS_U); bf16_t* Mb = (bf16_t*)(ws + WS_U);
    bf16_t* Yb = (bf16_t*)(ws + WS_YCAT);
    const float* mod = (const float*)(ws + WS_MOD);

    if (EN(0) && IN(0)) {
        for (int it = blockIdx.x; it < 192; it += gridDim.x) mod_item(lds, a, it);
        weights_phase(lds, a);
        SEAM(0);
    }
    if (EN(1) && IN(1)) { uprep_phase(a); SEAM(1); }
    for (int l = 0; l < DEPTH; ++l) {
        const int pb = 2 + 6 * l;
        if (EN(2) && IN(pb + 0)) {
            Gemm g{Ub, (const bf16_t*)(ws + WS_WIN) + (size_t)l * NIN * D, D, D, D, 0};
            StaticOrder S; S.init(T, NIN, gridDim.x, blockIdx.x);
            EpiH E{Hb};
            gemm_phase<EpiH>(lds, g, S, E);
            SEAM(pb + 0);
        }
        if (EN(3) && IN(pb + 1)) {
            for (int it = blockIdx.x; it < 512; it += gridDim.x) attn_item(lds, Hb, Yb, a.sinks + l * 16, it);
            for (int gi = blockIdx.x * NTHREADS + threadIdx.x; gi < 131072; gi += gridDim.x * NTHREADS) pool_build(Hb, Pb, gi);
            SEAM(pb + 1);
        }
        if (EN(4) && IN(pb + 2)) {
            Gemm g{Pb, (const bf16_t*)(ws + WS_WGRP) + (size_t)l * 4 * 65536, 1024, 256, 256, 512};
            StaticOrder S; S.init(T, 1024, gridDim.x, blockIdx.x);
            EpiPool E{Hb, a.pool_scale + l * 1024, Yb};
            gemm_phase<EpiPool>(lds, g, S, E);
            SEAM(pb + 2);
        }
        if (EN(5) && IN(pb + 3)) {
            Gemm g{Yb, (const bf16_t*)(ws + WS_WCAT) + (size_t)l * D * D, D, D, D, 0};
            StaticOrder S; S.init(T, D, gridDim.x, blockIdx.x);
            EpiMerge E{Hb, Mb};
            gemm_phase<EpiMerge>(lds, g, S, E);
            SEAM(pb + 3);
        }
        if (EN(6) && IN(pb + 4)) {
            Gemm g{Mb, (const bf16_t*)(ws + WS_WOUT) + (size_t)l * D * D, D, D, D, 0};
            StaticOrder S; S.init(T, D, gridDim.x, blockIdx.x);
            EpiZ E{l == 0 ? a.x : a.out, mod + (size_t)l * 8 * 6144 + 4096, Zb};
            gemm_phase<EpiZ>(lds, g, S, E);
            SEAM(pb + 4);
        }
        if (EN(7) && IN(pb + 5)) {
            ln_phase(Zb, a.ln_g + l * D, a.ln_b + l * D, a.out, mod + (size_t)(l + 1) * 8 * 6144, (l + 1 < DEPTH) ? Ub : nullptr);
            SEAM(pb + 5);
        }
    }
#undef IN
#undef SEAM
}

extern "C" void kernel_launch(void* const* d_in, const int* in_sizes, int n_in, void* d_out, int out_size, void* d_ws, size_t ws_size, hipStream_t stream) {
    static int grid = 0;
    if (grid == 0) {
        if (n_in != 13 || in_sizes[0] != T * D || out_size != T * D || ws_size < WS_END) {
            fprintf(stderr, "kernel_launch: unexpected problem (n_in %d, in0 %d, out %d, ws %zu, need %zu); nothing launched\n", n_in, n_in > 0 ? in_sizes[0] : -1, out_size, ws_size, (size_t)WS_END);
            grid = -1; return; }
        int dev = 0, cus = 0, per_cu = 0;
        if (hipGetDevice(&dev) != hipSuccess || hipDeviceGetAttribute(&cus, hipDeviceAttributeMultiprocessorCount, dev) != hipSuccess) { grid = -1; return; }
        if (hipFuncSetAttribute((const void*)fwd_megakernel, hipFuncAttributeMaxDynamicSharedMemorySize, LDS_BYTES) != hipSuccess) { fprintf(stderr, "kernel_launch: hipFuncSetAttribute failed\n"); grid = -1; return; }
        if (hipOccupancyMaxActiveBlocksPerMultiprocessor(&per_cu, (const void*)fwd_megakernel, NTHREADS, LDS_BYTES) != hipSuccess || per_cu < 1) { fprintf(stderr, "kernel_launch: occupancy query says %d blocks per CU\n", per_cu); grid = -1; return; }
        grid = cus;
    }
    if (grid < 0) return;
    Args a{};
    a.x = (const float*)d_in[0]; a.c = (const float*)d_in[1]; a.w_ada = (const float*)d_in[2]; a.b_ada = (const float*)d_in[3]; a.w_in = (const float*)d_in[4];
    a.w_pool_grp = (const float*)d_in[5]; a.pool_scale = (const float*)d_in[6]; a.sinks = (const float*)d_in[7]; a.w_pool_up = (const float*)d_in[8];
    a.w_attn_up = (const float*)d_in[9]; a.w_out = (const float*)d_in[10]; a.ln_g = (const float*)d_in[11]; a.ln_b = (const float*)d_in[12];
    a.out = (float*)d_out; a.ws = (unsigned char*)d_ws;
#if MK_PER_PHASE_LAUNCH
    for (int p = 0; p < N_PHASES; ++p) {
        a.ph_lo = p; a.ph_hi = p + 1;
        void* args[] = {&a};
        hipError_t e = hipLaunchCooperativeKernel((const void*)fwd_megakernel, dim3(grid), dim3(NTHREADS), args, LDS_BYTES, stream);
        if (e != hipSuccess) { fprintf(stderr, "kernel_launch: cooperative launch failed: %s\n", hipGetErrorString(e)); return; }
    }
#else
    a.ph_lo = 0; a.ph_hi = N_PHASES;
    void* args[] = {&a};
    hipError_t e = hipLaunchCooperativeKernel((const void*)fwd_megakernel, dim3(grid), dim3(NTHREADS), args, LDS_BYTES, stream);
    if (e != hipSuccess) fprintf(stderr, "kernel_launch: cooperative launch failed: %s (grid %d)\n", hipGetErrorString(e), grid);
#endif
}
```

```cpp
#include <hip/hip_runtime.h>
#include <hip/hip_cooperative_groups.h>
#include <cstdio>
namespace cg = cooperative_groups;

#define LAS __attribute__((address_space(3)))
typedef unsigned short bf16_t;
typedef short bf16x8 __attribute__((ext_vector_type(8)));
typedef float f32x4 __attribute__((ext_vector_type(4)));
typedef unsigned u32x4 __attribute__((ext_vector_type(4)));
typedef unsigned u32x2 __attribute__((ext_vector_type(2)));

constexpr int D = 2048, NBATCH = 8, SEQ = 2048, T = NBATCH * SEQ, NIN = 8704, DEPTH = 2;
constexpr int OFF_PGATE = 1024, OFF_Q = 2048, OFF_K = 3072, OFF_V = 3328, OFF_AGATE = 3584, OFF_GP = 4608, OFF_GA = 6656;
constexpr float ALPHA = 1.41421356237f, LN_EPS = 1e-5f, LOG2E = 1.44269504089f;
constexpr int NTHREADS = 512, LDS_MAIN = 131072, LDS_BYTES = LDS_MAIN + 16;

constexpr size_t WS_WIN = 0;
constexpr size_t WS_WCAT = WS_WIN + (size_t)2 * NIN * D * 2;
constexpr size_t WS_WOUT = WS_WCAT + (size_t)2 * D * D * 2;
constexpr size_t WS_WGRP = WS_WOUT + (size_t)2 * D * D * 2;
constexpr size_t WS_MOD = WS_WGRP + (size_t)2 * 4 * 256 * 256 * 2;
constexpr size_t WS_U = WS_MOD + (size_t)2 * 8 * 6144 * 4;
constexpr size_t WS_H = WS_U + (size_t)T * D * 2;
constexpr size_t WS_YCAT = WS_H + (size_t)T * NIN * 2;
constexpr size_t WS_BAR = WS_YCAT + (size_t)T * D * 2;
constexpr size_t WS_END = WS_BAR + 16384;

__device__ __forceinline__ unsigned cvt_pk_bf16(float lo, float hi) { unsigned r; asm volatile("v_cvt_pk_bf16_f32 %0, %1, %2" : "=v"(r) : "v"(lo), "v"(hi)); return r; }
__device__ __forceinline__ float bf_lo(unsigned w) { return __uint_as_float(w << 16); }
__device__ __forceinline__ float bf_hi(unsigned w) { return __uint_as_float(w & 0xffff0000u); }
__device__ __forceinline__ float fast_sigmoid(float x) { return __builtin_amdgcn_rcpf(1.0f + __builtin_amdgcn_exp2f(-x * LOG2E)); }

constexpr int BM = 256, BK = 64, HALF = 128, HTB = HALF * BK * 2, NXCD = 8, WGM = 8;
__device__ __forceinline__ int lds_byte(int r, int c) { const int st = (r >> 4) * 2 + (c >> 5), rr = r & 15, cc = c & 31, ob = rr * 64 + cc * 2; return st * 1024 + (ob ^ (((ob >> 9) & 1) << 5)); }
__device__ __forceinline__ void stage_rc(int b, int& R, int& C) { const int st = b / 1024, sb = b % 1024, swz = sb ^ (((sb >> 9) & 1) << 5); R = (st >> 1) * 16 + swz / 64; C = (st & 1) * 32 + (swz % 64) / 2; }
__device__ __forceinline__ int perm32(int rho) { const int n = rho >> 4, i = rho & 15; return 8 * (i >> 2) + 4 * n + (i & 3); }

struct Unit { int pm, pn; };
struct Gemm { const bf16_t* A; const bf16_t* Bt; int lda, ldb, K, a_pn_bytes; };
struct StaticOrder {
    int nM, nN, nwg, G, c;
    __device__ void init(int M, int N, int G_, int c_) { nM = M / BM; nN = N / BM; nwg = nM * nN; G = G_; c = c_; }
    __device__ bool next(int i, Unit& u) const {
        const long L = (long)i * G + c; if (L >= nwg) return false;
        int wgid = (int)L; { const int q = nwg / NXCD, r = nwg % NXCD, xcd = wgid % NXCD, off = wgid / NXCD; wgid = (xcd < r ? xcd * (q + 1) : r * (q + 1) + (xcd - r) * q) + off; }
        const int nig = WGM * nN, gid = wgid / nig, fm = gid * WGM, gsz = (nM - fm) < WGM ? (nM - fm) : WGM;
        u.pm = fm + ((wgid % nig) % gsz); u.pn = (wgid % nig) / gsz; return true;
    }
};


struct EpiH {
    static constexpr bool PERM = true, MID = false;
    bf16_t* O;
    __device__ __forceinline__ void mid(f32x4 (&)[2][2][4][2], const Unit&, int, int, int, int) const {}
    __device__ __forceinline__ void operator()(const f32x4 (&acc)[2][2][4][2], const Unit& u, int wr, int wc, int fr, int fq) const {
        const int pn = u.pn;
        const int act = (pn < 4) ? 0 : (pn < 8) ? 1 : (pn < 14) ? 0 : (pn < 18) ? 1 : 2;
        const float sc = (pn >= 8 && pn < 12) ? 0.125f : 1.0f;
        const int row0 = u.pm * BM + wr * 64 + fr, col0 = pn * BM + wc * 32 + 8 * fq;
#pragma unroll
        for (int ai = 0; ai < 2; ++ai)
#pragma unroll
            for (int m = 0; m < 4; ++m) { bf16_t* rowp = O + (size_t)(row0 + ai * HALF + m * 16) * NIN + col0;
#pragma unroll
                for (int bj = 0; bj < 2; ++bj) { f32x4 v0 = acc[ai][bj][m][0], v1 = acc[ai][bj][m][1];
                    if (act == 1) {
#pragma unroll
                        for (int j = 0; j < 4; ++j) { v0[j] = v0[j] * fast_sigmoid(v0[j]); v1[j] = v1[j] * fast_sigmoid(v1[j]); }
                    } else if (act == 2) {
#pragma unroll
                        for (int j = 0; j < 4; ++j) { v0[j] = fast_sigmoid(v0[j]); v1[j] = fast_sigmoid(v1[j]); }
                    } else { v0 = v0 * sc; v1 = v1 * sc; }
                    u32x4 w; w.x = cvt_pk_bf16(v0[0], v0[1]); w.y = cvt_pk_bf16(v0[2], v0[3]); w.z = cvt_pk_bf16(v1[0], v1[1]); w.w = cvt_pk_bf16(v1[2], v1[3]);
                    *(u32x4*)(rowp + bj * HALF) = w; } }
    }
};
struct EpiPool {
    static constexpr bool PERM = true, MID = false;
    const bf16_t* H; const float* pscale; bf16_t* Y;
    __device__ __forceinline__ void mid(f32x4 (&)[2][2][4][2], const Unit&, int, int, int, int) const {}
    __device__ __forceinline__ void operator()(const f32x4 (&acc)[2][2][4][2], const Unit& u, int wr, int wc, int fr, int fq) const {
        const int row0 = u.pm * BM + wr * 64 + fr, col0 = u.pn * BM + wc * 32 + 8 * fq;
        f32x4 ps[2][2];
#pragma unroll
        for (int bj = 0; bj < 2; ++bj) { ps[bj][0] = *(const f32x4*)(pscale + col0 + bj * HALF); ps[bj][1] = *(const f32x4*)(pscale + col0 + bj * HALF + 4); }
#pragma unroll
        for (int ai = 0; ai < 2; ++ai)
#pragma unroll
            for (int m = 0; m < 4; ++m) { const size_t r = (size_t)(row0 + ai * HALF + m * 16);
#pragma unroll
                for (int bj = 0; bj < 2; ++bj) {
                    const u32x4 g = *(const u32x4*)(H + r * NIN + OFF_PGATE + col0 + bj * HALF);
                    const f32x4 v0 = acc[ai][bj][m][0] * ps[bj][0], v1 = acc[ai][bj][m][1] * ps[bj][1];
                    u32x4 w; w.x = cvt_pk_bf16(v0[0] * bf_lo(g.x), v0[1] * bf_hi(g.x)); w.y = cvt_pk_bf16(v0[2] * bf_lo(g.y), v0[3] * bf_hi(g.y));
                    w.z = cvt_pk_bf16(v1[0] * bf_lo(g.z), v1[1] * bf_hi(g.z)); w.w = cvt_pk_bf16(v1[2] * bf_lo(g.w), v1[3] * bf_hi(g.w));
                    *(u32x4*)(Y + r * D + col0 + bj * HALF) = w; }
                asm volatile("" ::: "memory"); }
    }
};
struct EpiMerge {
    static constexpr bool PERM = true, MID = true;
    const bf16_t* H; bf16_t* O;
    __device__ __forceinline__ void mid(f32x4 (&acc)[2][2][4][2], const Unit& u, int wr, int wc, int fr, int fq) const {
        int row0 = u.pm * BM + wr * 64 + fr, col0 = u.pn * BM + wc * 32 + 8 * fq;
        asm volatile("" : "+v"(row0), "+v"(col0));
#pragma unroll
        for (int ai = 0; ai < 2; ++ai)
#pragma unroll
            for (int m = 0; m < 4; ++m) { const bf16_t* hp = H + (size_t)(row0 + ai * HALF + m * 16) * NIN + col0;
#pragma unroll
                for (int bj = 0; bj < 2; ++bj) {
                    const u32x4 gp = *(const u32x4*)(hp + OFF_GP + bj * HALF), ga = *(const u32x4*)(hp + OFF_GA + bj * HALF);
                    f32x4 r0, r1;
                    r0[0] = bf_lo(gp.x) * __builtin_amdgcn_rcpf(fmaxf(bf_lo(ga.x), 1e-30f)); r0[1] = bf_hi(gp.x) * __builtin_amdgcn_rcpf(fmaxf(bf_hi(ga.x), 1e-30f));
                    r0[2] = bf_lo(gp.y) * __builtin_amdgcn_rcpf(fmaxf(bf_lo(ga.y), 1e-30f)); r0[3] = bf_hi(gp.y) * __builtin_amdgcn_rcpf(fmaxf(bf_hi(ga.y), 1e-30f));
                    r1[0] = bf_lo(gp.z) * __builtin_amdgcn_rcpf(fmaxf(bf_lo(ga.z), 1e-30f)); r1[1] = bf_hi(gp.z) * __builtin_amdgcn_rcpf(fmaxf(bf_hi(ga.z), 1e-30f));
                    r1[2] = bf_lo(gp.w) * __builtin_amdgcn_rcpf(fmaxf(bf_lo(ga.w), 1e-30f)); r1[3] = bf_hi(gp.w) * __builtin_amdgcn_rcpf(fmaxf(bf_hi(ga.w), 1e-30f));
                    acc[ai][bj][m][0] = acc[ai][bj][m][0] * r0; acc[ai][bj][m][1] = acc[ai][bj][m][1] * r1; }
                asm volatile("" ::: "memory"); }
    }
    __device__ __forceinline__ void operator()(const f32x4 (&acc)[2][2][4][2], const Unit& u, int wr, int wc, int fr, int fq) const {
        const int row0 = u.pm * BM + wr * 64 + fr, col0 = u.pn * BM + wc * 32 + 8 * fq;
#pragma unroll
        for (int ai = 0; ai < 2; ++ai)
#pragma unroll
            for (int m = 0; m < 4; ++m) { const size_t r = (size_t)(row0 + ai * HALF + m * 16);
#pragma unroll
                for (int bj = 0; bj < 2; ++bj) {
                    const u32x4 ga = *(const u32x4*)(H + r * NIN + OFF_GA + col0 + bj * HALF);
                    const f32x4 v0 = acc[ai][bj][m][0], v1 = acc[ai][bj][m][1];
                    u32x4 w; w.x = cvt_pk_bf16(v0[0] * bf_lo(ga.x), v0[1] * bf_hi(ga.x)); w.y = cvt_pk_bf16(v0[2] * bf_lo(ga.y), v0[3] * bf_hi(ga.y));
                    w.z = cvt_pk_bf16(v1[0] * bf_lo(ga.z), v1[1] * bf_hi(ga.z)); w.w = cvt_pk_bf16(v1[2] * bf_lo(ga.w), v1[3] * bf_hi(ga.w));
                    *(u32x4*)(O + r * D + col0 + bj * HALF) = w; }
                asm volatile("" ::: "memory"); }
    }
};
struct EpiZ {
    static constexpr bool PERM = false, MID = false;
    const float* X; const float* gate; float* Z;
    __device__ __forceinline__ void mid(f32x4 (&)[2][2][4][2], const Unit&, int, int, int, int) const {}
    __device__ __forceinline__ void operator()(const f32x4 (&acc)[2][2][4][2], const Unit& u, int wr, int wc, int fr, int fq) const {
        const int row0 = u.pm * BM + wr * 64 + fr, col0 = u.pn * BM + wc * 32 + 4 * fq;
        const float* gp = gate + (size_t)(u.pm >> 3) * 6144 + col0;
        f32x4 gv[2][2];
#pragma unroll
        for (int bj = 0; bj < 2; ++bj)
#pragma unroll
            for (int n = 0; n < 2; ++n) gv[bj][n] = *(const f32x4*)(gp + bj * HALF + n * 16);
#pragma unroll
        for (int ai = 0; ai < 2; ++ai)
#pragma unroll
            for (int m = 0; m < 4; ++m) { const size_t off = (size_t)(row0 + ai * HALF + m * 16) * D + col0;
#pragma unroll
                for (int bj = 0; bj < 2; ++bj)
#pragma unroll
                    for (int n = 0; n < 2; ++n) { const f32x4 xv = *(const f32x4*)(X + off + bj * HALF + n * 16);
                        *(f32x4*)(Z + off + bj * HALF + n * 16) = xv * ALPHA + gv[bj][n] * acc[ai][bj][m][n]; } }
    }
};

template <class Epi>
__device__ __forceinline__ void gemm_phase(LAS unsigned char* lds, const Gemm g, const StaticOrder& S, const Epi& E) {
    int tid = threadIdx.x; asm volatile("" : "+v"(tid));
    const int wid = __builtin_amdgcn_readfirstlane(tid >> 6), lane = tid & 63, wr = wid >> 2, wc = wid & 3, fr = lane & 15, fq = lane >> 4;
    int Kv = g.K; asm volatile("" : "+s"(Kv));
    const int nt = Kv / BK;
    unsigned voffA[2], voffB[2];
#pragma unroll
    for (int i = 0; i < 2; ++i) { int R, C; stage_rc(tid * 16 + i * 8192, R, C); const int Rb = Epi::PERM ? ((R & ~31) + perm32(R & 31)) : R;
        voffA[i] = (unsigned)(R * g.lda + C) * 2u; voffB[i] = (unsigned)(Rb * g.ldb + C) * 2u; }
    const size_t kstep = (size_t)(BK * 2);
    const size_t hstepA = (size_t)HALF * g.lda * 2, hstepB = (size_t)HALF * g.ldb * 2;
    const size_t tstepA = 2 * hstepA, tstepB = 2 * hstepB;
    const unsigned ldsw = (unsigned)wid * 1024u;
    const int aoff = lds_byte(wr * 64 + fr, fq * 8), boff = lds_byte(wc * 32 + fr, fq * 8);
#define PG8_SA(b, h) (((b) * 2 + (h)) * HTB)
#define PG8_SB(b, h) ((4 + (b) * 2 + (h)) * HTB)
#define PG8_STAGE(bufoff, gbase, voff) do { _Pragma("unroll") for (int _i = 0; _i < 2; ++_i) \
        __builtin_amdgcn_global_load_lds((const unsigned*)((const char*)(gbase) + (voff)[_i]), (LAS unsigned*)(lds + (bufoff) + ldsw + _i * 8192), 16, 0, 0); } while (0)
#define PG8_LDA(dst, b, h) do { _Pragma("unroll") for (int m = 0; m < 4; ++m) _Pragma("unroll") for (int k = 0; k < 2; ++k) dst[m][k] = *(const LAS bf16x8*)(lds + PG8_SA(b, h) + aoff + m * 2048 + k * 1024); } while (0)
#define PG8_LDB(dst, b, h) do { _Pragma("unroll") for (int n = 0; n < 2; ++n) _Pragma("unroll") for (int k = 0; k < 2; ++k) dst[n][k] = *(const LAS bf16x8*)(lds + PG8_SB(b, h) + boff + n * 2048 + k * 1024); } while (0)
#define PG8_MMA(ai, bj, At, Bt) do { __builtin_amdgcn_s_setprio(1); _Pragma("unroll") for (int m = 0; m < 4; ++m) _Pragma("unroll") for (int n = 0; n < 2; ++n) _Pragma("unroll") for (int k = 0; k < 2; ++k) \
        acc[ai][bj][m][n] = __builtin_amdgcn_mfma_f32_16x16x32_bf16(Bt[n][k], At[m][k], acc[ai][bj][m][n], 0, 0, 0); __builtin_amdgcn_s_setprio(0); } while (0)
#define PG8_WAIT_V(n) asm volatile("s_waitcnt vmcnt(" #n ")" ::: "memory")
#define PG8_WAIT_L(n) asm volatile("s_waitcnt lgkmcnt(" #n ")" ::: "memory")
#define PG8_BAR __builtin_amdgcn_s_barrier()
#define PG8_SCHED __builtin_amdgcn_sched_barrier(0)
    Unit cur, nxt; int ui = 0;
    if (!S.next(0, cur)) return;
    f32x4 acc[2][2][4][2];
#pragma unroll
    for (int a = 0; a < 2; ++a)
#pragma unroll
        for (int b = 0; b < 2; ++b)
#pragma unroll
            for (int m = 0; m < 4; ++m)
#pragma unroll
                for (int n = 0; n < 2; ++n) acc[a][b][m][n] = (f32x4){0.f, 0.f, 0.f, 0.f};
    bf16x8 At[4][2], B0[2][2], B1[2][2];
    const char* cA = (const char*)g.A + (size_t)cur.pm * tstepA + (size_t)cur.pn * g.a_pn_bytes; const char* cB = (const char*)g.Bt + (size_t)cur.pn * tstepB;
    PG8_STAGE(PG8_SB(0, 0), cB, voffB); PG8_STAGE(PG8_SA(0, 0), cA, voffA); PG8_STAGE(PG8_SB(0, 1), cB + hstepB, voffB); PG8_STAGE(PG8_SA(0, 1), cA + hstepA, voffA);
    if (wr == 1) PG8_BAR;
    PG8_WAIT_V(4); PG8_BAR;
    PG8_STAGE(PG8_SB(1, 0), cB + kstep, voffB); PG8_STAGE(PG8_SA(1, 0), cA + kstep, voffA); PG8_STAGE(PG8_SB(1, 1), cB + hstepB + kstep, voffB);
    PG8_WAIT_V(6); PG8_BAR;
    for (;;) {
        const bool has_next = S.next(ui + 1, nxt);
        const char* nA = has_next ? (const char*)g.A + (size_t)nxt.pm * tstepA + (size_t)nxt.pn * g.a_pn_bytes : cA; const char* nB = has_next ? (const char*)g.Bt + (size_t)nxt.pn * tstepB : cB;
        for (int t = 0; t < nt; t += 2) {
            const bool last = (t == nt - 2);
            const char* a1 = cA + (size_t)(t + 1) * kstep;
            const char* a2 = last ? nA : cA + (size_t)(t + 2) * kstep; const char* b2 = last ? nB : cB + (size_t)(t + 2) * kstep;
            const char* a3 = a2 + kstep; const char* b3 = b2 + kstep;
            if constexpr (Epi::MID) { if (t == (nt >> 1)) E.mid(acc, cur, wr, wc, fr, fq); }
            PG8_LDB(B0, 0, 0); PG8_SCHED; PG8_LDA(At, 0, 0); PG8_STAGE(PG8_SA(1, 1), a1 + hstepA, voffA);
            PG8_WAIT_L(8); PG8_BAR; PG8_WAIT_L(0); PG8_MMA(0, 0, At, B0); PG8_BAR; PG8_SCHED;
            PG8_LDB(B1, 0, 1); PG8_STAGE(PG8_SB(0, 0), b2, voffB);
            PG8_BAR; PG8_WAIT_L(0); PG8_MMA(0, 1, At, B1); PG8_BAR;
            PG8_LDA(At, 0, 1); PG8_STAGE(PG8_SA(0, 0), a2, voffA);
            PG8_BAR; PG8_WAIT_L(0); PG8_MMA(1, 0, At, B0); PG8_BAR; PG8_SCHED;
            PG8_STAGE(PG8_SB(0, 1), b2 + hstepB, voffB);
            PG8_WAIT_V(6); PG8_BAR; PG8_MMA(1, 1, At, B1); PG8_BAR;
            PG8_LDB(B0, 1, 0); PG8_SCHED; PG8_LDA(At, 1, 0); PG8_STAGE(PG8_SA(0, 1), a2 + hstepA, voffA);
            PG8_WAIT_L(8); PG8_BAR; PG8_WAIT_L(0); PG8_MMA(0, 0, At, B0); PG8_BAR; PG8_SCHED;
            PG8_LDB(B1, 1, 1); PG8_STAGE(PG8_SB(1, 0), b3, voffB);
            PG8_BAR; PG8_WAIT_L(0); PG8_MMA(0, 1, At, B1); PG8_BAR;
            PG8_LDA(At, 1, 1); PG8_STAGE(PG8_SA(1, 0), a3, voffA);
            PG8_BAR; PG8_WAIT_L(0); PG8_MMA(1, 0, At, B0); PG8_BAR; PG8_SCHED;
            PG8_STAGE(PG8_SB(1, 1), b3 + hstepB, voffB);
            PG8_WAIT_V(6); PG8_BAR; PG8_MMA(1, 1, At, B1); PG8_BAR;
        }
        E(acc, cur, wr, wc, fr, fq);
        if (!has_next) break;
#pragma unroll
        for (int a = 0; a < 2; ++a)
#pragma unroll
            for (int b = 0; b < 2; ++b)
#pragma unroll
                for (int m = 0; m < 4; ++m)
#pragma unroll
                    for (int n = 0; n < 2; ++n) acc[a][b][m][n] = (f32x4){0.f, 0.f, 0.f, 0.f};
        cur = nxt; cA = nA; cB = nB; ++ui;
    }
    PG8_WAIT_V(0);
    if (wr == 0) PG8_BAR;
    PG8_BAR;
#undef PG8_SA
#undef PG8_SB
#undef PG8_STAGE
#undef PG8_LDA
#undef PG8_LDB
#undef PG8_MMA
#undef PG8_WAIT_V
#undef PG8_WAIT_L
#undef PG8_BAR
#undef PG8_SCHED
}

#define XB_TMO      128
#define XB_XCNT(j)  (256  + 64 * (j))
#define XB_XSUB(j)  (1280 + 64 * (j))
#define XB_XGEN(j)  (2304 + 64 * (j))
#define XB_TOP      3328
#define XB_TOPGEN   3392
#define XCD_BAR_WORDS 3456
#define XB_SPIN_CAP (1u << 18)
__device__ __forceinline__ unsigned xb_ld(unsigned* p)              { return __hip_atomic_load(p, __ATOMIC_RELAXED, __HIP_MEMORY_SCOPE_AGENT); }
__device__ __forceinline__ unsigned xb_add(unsigned* p, unsigned v) { return __hip_atomic_fetch_add(p, v, __ATOMIC_RELAXED, __HIP_MEMORY_SCOPE_AGENT); }
__device__ __forceinline__ unsigned xb_xcc_id() { return (unsigned)__builtin_amdgcn_s_getreg((3 << 11) | 20) & 0xFu; }
#define XB_SPIN(cond, bar) do { unsigned _sp = 0; while (cond) { __builtin_amdgcn_s_sleep(1); \
    if ((++_sp & 255u) == 0u) { if (xb_ld(&(bar)[XB_TMO])) break; if (_sp > XB_SPIN_CAP) { atomicAdd(&(bar)[XB_TMO], 1u); break; } } } } while (0)
struct XcdBarrier { unsigned* bar; unsigned x; volatile LAS unsigned* st; };
__device__ __forceinline__ XcdBarrier xcd_barrier_post(unsigned* bar, volatile LAS unsigned* st) {
    XcdBarrier b; b.bar = bar; b.x = xb_xcc_id(); b.st = st;
    if (threadIdx.x == 0) (void)xb_add(&bar[XB_XCNT(b.x)], 1u);
    return b;
}
__device__ __forceinline__ void xcd_barrier_complete(unsigned* bar, unsigned x, unsigned& nloc, unsigned& nx) {
    const unsigned G = gridDim.x * gridDim.y * gridDim.z;
    unsigned sum, cnt, mine, sp = 0u;
    for (;;) {
        sum = 0u; cnt = 0u; mine = 0u;
#pragma unroll
        for (unsigned j = 0; j < 16; ++j) { const unsigned c = xb_ld(&bar[XB_XCNT(j)]); sum += c; cnt += (c > 0u) ? 1u : 0u; mine = (j == x) ? c : mine; }
        if (sum == G) break;
        __builtin_amdgcn_s_sleep(1);
        if ((++sp & 255u) == 0u) { if (xb_ld(&bar[XB_TMO])) break; if (sp > XB_SPIN_CAP) { atomicAdd(&bar[XB_TMO], 1u); break; } }
    }
    nloc = mine > 0u ? mine : 1u; nx = cnt > 0u ? cnt : 1u;
}
__device__ __forceinline__ void xcd_barrier(const XcdBarrier& b) {
    asm volatile("s_waitcnt vmcnt(0)" ::: "memory");
    __syncthreads();
    if (threadIdx.x == 0) {
        unsigned* bar = b.bar;
        __builtin_amdgcn_s_waitcnt(0);
        unsigned nloc = b.st[0], nx = b.st[1];
        if (nloc == 0u) { xcd_barrier_complete(bar, b.x, nloc, nx); b.st[0] = nloc; b.st[1] = nx; }
        const unsigned old = xb_add(&bar[XB_XSUB(b.x)], 1u);
        const unsigned gen = old / nloc;
        if (old + 1u == (gen + 1u) * nloc) {
            __builtin_amdgcn_fence(__ATOMIC_RELEASE, "agent");
            asm volatile("s_waitcnt vmcnt(0)" ::: "memory");
            const unsigned og = xb_add(&bar[XB_TOP], 1u);
            const unsigned tg = og / nx;
            if (og + 1u == (tg + 1u) * nx) xb_add(&bar[XB_TOPGEN], 1u);
            else XB_SPIN(xb_ld(&bar[XB_TOPGEN]) == tg, bar);
            __builtin_amdgcn_fence(__ATOMIC_ACQUIRE, "agent");
            xb_add(&bar[XB_XGEN(b.x)], 1u);
            asm volatile("s_waitcnt vmcnt(0)" ::: "memory");
        } else {
            XB_SPIN(xb_ld(&bar[XB_XGEN(b.x)]) == gen, bar);
            __builtin_amdgcn_fence(__ATOMIC_ACQUIRE, "agent");
            asm volatile("s_waitcnt vmcnt(0)" ::: "memory");
        }
    }
    __syncthreads();
}

struct Args {
    const float* x; const float* c; const float* w_ada; const float* b_ada; const float* w_in; const float* w_pool_grp; const float* pool_scale;
    const float* sinks; const float* w_pool_up; const float* w_attn_up; const float* w_out; const float* ln_g; const float* ln_b;
    float* out; unsigned char* ws; int ph_lo, ph_hi;
};

__device__ void mod_item(LAS unsigned char* lds, const Args& a, int it) {
    const int tid = threadIdx.x;
    LAS float* sc = (LAS float*)lds;
    LAS float* red = (LAS float*)(lds + 65536);
    for (int i = tid; i < NBATCH * D; i += NTHREADS) { const float v = a.c[i]; sc[i] = v * fast_sigmoid(v); }
    __syncthreads();
    const int cq = tid & 15, ks = tid >> 4, l = it / 96, chunk = it % 96, col0 = chunk * 64 + cq * 4;
    const float* W = a.w_ada + (size_t)l * D * 6144 + col0;
    f32x4 acc[8];
#pragma unroll
    for (int b = 0; b < 8; ++b) acc[b] = (f32x4){0.f, 0.f, 0.f, 0.f};
#pragma unroll 4
    for (int k = ks; k < D; k += 32) { const f32x4 w = *(const f32x4*)(W + (size_t)k * 6144);
#pragma unroll
        for (int b = 0; b < 8; ++b) acc[b] += w * sc[b * D + k]; }
#pragma unroll
    for (int b = 0; b < 8; ++b) *(LAS f32x4*)(red + (ks * 8 + b) * 64 + cq * 4) = acc[b];
    __syncthreads();
    { const int b = tid >> 6, col = tid & 63; float s = 0.f;
#pragma unroll 8
      for (int k = 0; k < 32; ++k) s += red[(k * 8 + b) * 64 + col];
      float* mod = (float*)(a.ws + WS_MOD);
      mod[((size_t)l * 8 + b) * 6144 + chunk * 64 + col] = s + a.b_ada[(size_t)l * 6144 + chunk * 64 + col]; }
    __syncthreads();
}

__device__ void wt_tile(LAS unsigned char* lds, const float* src, int lds_src, bf16_t* dst, int ld_dst, int k0, int n0) {
    const int tid = threadIdx.x;
    LAS unsigned* tile = (LAS unsigned*)lds;
    const int c4 = tid & 15, r = tid >> 4;
#pragma unroll
    for (int j = 0; j < 2; ++j) { const int kp = r + 32 * j;
        const f32x4 v0 = *(const f32x4*)(src + (size_t)(k0 + 2 * kp) * lds_src + n0 + 4 * c4);
        const f32x4 v1 = *(const f32x4*)(src + (size_t)(k0 + 2 * kp + 1) * lds_src + n0 + 4 * c4);
#pragma unroll
        for (int e = 0; e < 4; ++e) tile[(4 * c4 + e) * 65 + kp] = cvt_pk_bf16(v0[e], v1[e]); }
    __syncthreads();
    const int w = tid >> 6, lane = tid & 63;
#pragma unroll
    for (int n = w; n < 64; n += 8) *(unsigned*)(dst + (size_t)(n0 + n) * ld_dst + k0 + 2 * lane) = tile[n * 65 + lane];
    __syncthreads();
}
__device__ void weights_phase(LAS unsigned char* lds, const Args& a) {
    constexpr int PER_LAYER = 3232;
    for (int id = blockIdx.x; id < 2 * PER_LAYER; id += gridDim.x) {
        const int l = id / PER_LAYER; int t = id % PER_LAYER;
        const float* src; int ls; bf16_t* dst; int ld; int k0, n0;
        if (t < 2176) { src = a.w_in + (size_t)l * D * NIN; ls = NIN; dst = (bf16_t*)(a.ws + WS_WIN) + (size_t)l * NIN * D; ld = D; n0 = (t % 136) * 64; k0 = (t / 136) * 128; }
        else if (t < 2176 + 256) { t -= 2176; src = a.w_pool_up + (size_t)l * 1024 * D; ls = D; dst = (bf16_t*)(a.ws + WS_WCAT) + (size_t)l * D * D; ld = D; n0 = (t % 32) * 64; k0 = (t / 32) * 128; }
        else if (t < 2176 + 512) { t -= 2176 + 256; src = a.w_attn_up + (size_t)l * 1024 * D; ls = D; dst = (bf16_t*)(a.ws + WS_WCAT) + (size_t)l * D * D + 1024; ld = D; n0 = (t % 32) * 64; k0 = (t / 32) * 128; }
        else if (t < 2176 + 1024) { t -= 2176 + 512; src = a.w_out + (size_t)l * D * D; ls = D; dst = (bf16_t*)(a.ws + WS_WOUT) + (size_t)l * D * D; ld = D; n0 = (t % 32) * 64; k0 = (t / 32) * 128; }
        else { t -= 2176 + 1024; const int g = t >> 3; t &= 7; src = a.w_pool_grp + ((size_t)l * 4 + g) * 65536; ls = 256; dst = (bf16_t*)(a.ws + WS_WGRP) + ((size_t)l * 4 + g) * 65536; ld = 256; n0 = (t & 3) * 64; k0 = (t >> 2) * 128; }
        wt_tile(lds, src, ls, dst, ld, k0, n0);
    }
}

__device__ void uprep_phase(const Args& a) {
    const float* __restrict__ mod = (const float*)(a.ws + WS_MOD);
    bf16_t* __restrict__ U = (bf16_t*)(a.ws + WS_U);
    const float* __restrict__ X = a.x;
    const size_t stride = (size_t)gridDim.x * NTHREADS;
    for (size_t i0 = (size_t)blockIdx.x * NTHREADS + threadIdx.x; i0 < (size_t)T * D / 8; i0 += 4 * stride) {
        f32x4 x0[4], x1[4];
#pragma unroll
        for (int j = 0; j < 4; ++j) { const size_t i = i0 + j * stride; if (i < (size_t)T * D / 8) { x0[j] = *(const f32x4*)(X + i * 8); x1[j] = *(const f32x4*)(X + i * 8 + 4); } }
#pragma unroll
        for (int j = 0; j < 4; ++j) { const size_t i = i0 + j * stride; if (i < (size_t)T * D / 8) {
            const size_t row = i >> 8; const int c8 = (int)(i & 255) * 8; const int b = (int)(row >> 11);
            const float* mp = mod + (size_t)b * 6144 + c8;
            const f32x4 sh0 = *(const f32x4*)(mp), sh1 = *(const f32x4*)(mp + 4), s0 = *(const f32x4*)(mp + 2048), s1 = *(const f32x4*)(mp + 2052);
            const f32x4 u0 = x0[j] * (s0 + 1.0f) + sh0, u1 = x1[j] * (s1 + 1.0f) + sh1;
            u32x4 w; w.x = cvt_pk_bf16(u0[0], u0[1]); w.y = cvt_pk_bf16(u0[2], u0[3]); w.z = cvt_pk_bf16(u1[0], u1[1]); w.w = cvt_pk_bf16(u1[2], u1[3]);
            *(u32x4*)(U + i * 8) = w; } }
    }
}

__device__ void attn_item(LAS unsigned char* lds, const bf16_t* H, bf16_t* Y, const float* sinks, int it) {
    int tid = threadIdx.x; asm volatile("" : "+v"(tid));
    const int lane = tid & 63, wave = __builtin_amdgcn_readfirstlane(tid >> 6), ln = lane & 15, g = lane >> 4;
    const int b = it >> 6, nb = (it >> 2) & 15, kvh = it & 3;
    LAS bf16_t* Ks = (LAS bf16_t*)lds;
    LAS bf16_t* Vt = (LAS bf16_t*)(lds + 36864);
#pragma unroll
    for (int j = 0; j < 4; ++j) {
        const int idx = tid + NTHREADS * j, key = idx >> 3, ch = idx & 7, s = nb * 128 - 128 + key;
        u32x4 kv = (u32x4){0u, 0u, 0u, 0u}, vv = (u32x4){0u, 0u, 0u, 0u};
        if (s >= 0) { const bf16_t* rp = H + ((size_t)b * SEQ + s) * NIN + kvh * 64 + ch * 8; kv = *(const u32x4*)(rp + OFF_K); vv = *(const u32x4*)(rp + OFF_V); }
        *(LAS u32x4*)(Ks + key * 72 + ch * 8) = kv;
        const int kk = key & 31, pos = (key & ~31) + ((kk & 15) >> 2) * 8 + (kk >> 4) * 4 + (kk & 3);
        const unsigned vw[4] = {vv.x, vv.y, vv.z, vv.w};
#pragma unroll
        for (int e = 0; e < 8; ++e) { const int d = ch * 8 + e, slot = 16 * ((d >> 2) & 3) + 4 * (d >> 4) + (d & 3);
            Vt[slot * 264 + pos] = (bf16_t)((e & 1) ? (vw[e >> 1] >> 16) : (vw[e >> 1] & 0xffffu)); }
    }
    __syncthreads();
    for (int tk = wave; tk < 16; tk += 8) {
        const int qsub = tk & 3, head = tk >> 2, hq = kvh * 4 + head, r0 = qsub * 32;
        const size_t qrow0 = (size_t)b * SEQ + nb * 128 + r0;
        bf16x8 qf[2][2];
#pragma unroll
        for (int qt = 0; qt < 2; ++qt)
#pragma unroll
            for (int kk = 0; kk < 2; ++kk) qf[qt][kk] = *(const bf16x8*)(H + (qrow0 + 16 * qt + ln) * NIN + OFF_Q + hq * 64 + 32 * kk + 8 * g);
        f32x4 s[10][2];
#pragma unroll
        for (int kt = 0; kt < 10; ++kt) { s[kt][0] = (f32x4){0.f, 0.f, 0.f, 0.f}; s[kt][1] = (f32x4){0.f, 0.f, 0.f, 0.f}; }
#pragma unroll
        for (int kt = 0; kt < 10; ++kt)
#pragma unroll
            for (int kk = 0; kk < 2; ++kk) { const bf16x8 kf = *(const LAS bf16x8*)(Ks + (r0 + 16 * kt + ln) * 72 + 32 * kk + 8 * g);
                s[kt][0] = __builtin_amdgcn_mfma_f32_16x16x32_bf16(kf, qf[0][kk], s[kt][0], 0, 0, 0);
                s[kt][1] = __builtin_amdgcn_mfma_f32_16x16x32_bf16(kf, qf[1][kk], s[kt][1], 0, 0, 0); }
        const float sink = sinks[hq];
        const int kmin = (nb == 0) ? 128 : 0;
        float inv[2], mx[2];
#pragma unroll
        for (int qt = 0; qt < 2; ++qt) {
            const int qr = 16 * qt + ln; float m = -INFINITY;
#pragma unroll
            for (int kt = 0; kt < 10; ++kt)
#pragma unroll
                for (int e = 0; e < 4; ++e) { const int kr = 16 * kt + 4 * g + e; const bool valid = (kr > qr) && (kr <= qr + 128) && (r0 + kr >= kmin);
                    const float v = valid ? s[kt][qt][e] : -INFINITY; s[kt][qt][e] = v; m = fmaxf(m, v); }
            m = fmaxf(m, __shfl_xor(m, 16)); m = fmaxf(m, __shfl_xor(m, 32)); m = fmaxf(m, sink);
            float sum = 0.f;
#pragma unroll
            for (int kt = 0; kt < 10; ++kt)
#pragma unroll
                for (int e = 0; e < 4; ++e) { const float p = __builtin_amdgcn_exp2f((s[kt][qt][e] - m) * LOG2E); s[kt][qt][e] = p; sum += p; }
            sum += __shfl_xor(sum, 16); sum += __shfl_xor(sum, 32);
            sum += __builtin_amdgcn_exp2f((sink - m) * LOG2E);
            inv[qt] = 1.0f / sum; mx[qt] = m;
        }
        f32x4 o[4][2];
#pragma unroll
        for (int dt = 0; dt < 4; ++dt) { o[dt][0] = (f32x4){0.f, 0.f, 0.f, 0.f}; o[dt][1] = (f32x4){0.f, 0.f, 0.f, 0.f}; }
#pragma unroll
        for (int pp = 0; pp < 5; ++pp) {
            bf16x8 pf[2];
#pragma unroll
            for (int qt = 0; qt < 2; ++qt) { const f32x4 p0 = s[2 * pp][qt] * inv[qt], p1 = s[2 * pp + 1][qt] * inv[qt];
                u32x4 w; w.x = cvt_pk_bf16(p0[0], p0[1]); w.y = cvt_pk_bf16(p0[2], p0[3]); w.z = cvt_pk_bf16(p1[0], p1[1]); w.w = cvt_pk_bf16(p1[2], p1[3]);
                pf[qt] = __builtin_bit_cast(bf16x8, w); }
#pragma unroll
            for (int dt = 0; dt < 4; ++dt) { const bf16x8 vf = *(const LAS bf16x8*)(Vt + (16 * dt + ln) * 264 + r0 + 32 * pp + 8 * g);
                o[dt][0] = __builtin_amdgcn_mfma_f32_16x16x32_bf16(vf, pf[0], o[dt][0], 0, 0, 0);
                o[dt][1] = __builtin_amdgcn_mfma_f32_16x16x32_bf16(vf, pf[1], o[dt][1], 0, 0, 0); }
        }
        (void)mx;
#pragma unroll
        for (int qt = 0; qt < 2; ++qt) { const size_t row = qrow0 + 16 * qt + ln;
            const bf16_t* gp = H + row * NIN + OFF_AGATE + hq * 64 + 16 * g;
            const u32x4 g0 = *(const u32x4*)gp, g1 = *(const u32x4*)(gp + 8);
            u32x4 w0, w1;
            w0.x = cvt_pk_bf16(o[0][qt][0] * bf_lo(g0.x), o[0][qt][1] * bf_hi(g0.x)); w0.y = cvt_pk_bf16(o[0][qt][2] * bf_lo(g0.y), o[0][qt][3] * bf_hi(g0.y));
            w0.z = cvt_pk_bf16(o[1][qt][0] * bf_lo(g0.z), o[1][qt][1] * bf_hi(g0.z)); w0.w = cvt_pk_bf16(o[1][qt][2] * bf_lo(g0.w), o[1][qt][3] * bf_hi(g0.w));
            w1.x = cvt_pk_bf16(o[2][qt][0] * bf_lo(g1.x), o[2][qt][1] * bf_hi(g1.x)); w1.y = cvt_pk_bf16(o[2][qt][2] * bf_lo(g1.y), o[2][qt][3] * bf_hi(g1.y));
            w1.z = cvt_pk_bf16(o[3][qt][0] * bf_lo(g1.z), o[3][qt][1] * bf_hi(g1.z)); w1.w = cvt_pk_bf16(o[3][qt][2] * bf_lo(g1.w), o[3][qt][3] * bf_hi(g1.w));
            bf16_t* yp = Y + row * D + 1024 + hq * 64 + 16 * g;
            *(u32x4*)yp = w0; *(u32x4*)(yp + 8) = w1; }
    }
    __syncthreads();
}

__device__ void pool_build(const bf16_t* H, bf16_t* P, int gidx) {
    const int lane = gidx & 63, wv = gidx >> 6;
    const int grp = wv & 3, rp = wv >> 2;
    const int run = rp * 2 + (lane >> 5), c8 = grp * 32 + (lane & 31);
    const int w = 2 << grp, t0 = run * 16, pos0 = t0 & (SEQ - 1);
    const bf16_t* hp = H + (size_t)t0 * NIN + c8 * 8;
    float sum[8];
#pragma unroll
    for (int e = 0; e < 8; ++e) sum[e] = 0.f;
    for (int j = 1; j < w; ++j) if (pos0 - j >= 0) { const u32x4 v = *(const u32x4*)(hp - (size_t)j * NIN);
        sum[0] += bf_lo(v.x); sum[1] += bf_hi(v.x); sum[2] += bf_lo(v.y); sum[3] += bf_hi(v.y); sum[4] += bf_lo(v.z); sum[5] += bf_hi(v.z); sum[6] += bf_lo(v.w); sum[7] += bf_hi(v.w); }
    for (int i = 0; i < 16; ++i) {
        const u32x4 v = *(const u32x4*)(hp + (size_t)i * NIN);
        const float cur[8] = {bf_lo(v.x), bf_hi(v.x), bf_lo(v.y), bf_hi(v.y), bf_lo(v.z), bf_hi(v.z), bf_lo(v.w), bf_hi(v.w)};
        const int cnt = min(pos0 + i + 1, w); const float rc = 1.0f / (float)cnt;
        float o[8];
#pragma unroll
        for (int e = 0; e < 8; ++e) { sum[e] += cur[e]; o[e] = sum[e] * rc - cur[e]; }
        u32x4 wv4; wv4.x = cvt_pk_bf16(o[0], o[1]); wv4.y = cvt_pk_bf16(o[2], o[3]); wv4.z = cvt_pk_bf16(o[4], o[5]); wv4.w = cvt_pk_bf16(o[6], o[7]);
        *(u32x4*)(P + (size_t)(t0 + i) * 1024 + c8 * 8) = wv4;
        if (pos0 + i - (w - 1) >= 0) { const u32x4 q = *(const u32x4*)(hp + (ptrdiff_t)(i - (w - 1)) * NIN);
            sum[0] -= bf_lo(q.x); sum[1] -= bf_hi(q.x); sum[2] -= bf_lo(q.y); sum[3] -= bf_hi(q.y); sum[4] -= bf_lo(q.z); sum[5] -= bf_hi(q.z); sum[6] -= bf_lo(q.w); sum[7] -= bf_hi(q.w); }
    }
}

__device__ void ln_phase(const float* __restrict__ Z, const float* __restrict__ lg, const float* __restrict__ lb, float* __restrict__ xout, const float* __restrict__ modn, bf16_t* __restrict__ U) {
    int tid = threadIdx.x; asm volatile("" : "+v"(tid));
    const int lane = tid & 63, wave = tid >> 6;
    const int rstride = gridDim.x * 8;
    for (int row0 = blockIdx.x * 8 + wave; row0 < T; row0 += 2 * rstride) {
        f32x4 v[2][8]; float s[2] = {0.f, 0.f};
        const bool has1 = (row0 + rstride) < T;
#pragma unroll
        for (int r = 0; r < 2; ++r) { const int row = (r && has1) ? row0 + rstride : row0; const float* zp = Z + (size_t)row * D + lane * 4;
#pragma unroll
            for (int j = 0; j < 8; ++j) v[r][j] = *(const f32x4*)(zp + j * 256); }
#pragma unroll
        for (int r = 0; r < 2; ++r)
#pragma unroll
            for (int j = 0; j < 8; ++j) s[r] += (v[r][j][0] + v[r][j][1]) + (v[r][j][2] + v[r][j][3]);
#pragma unroll
        for (int o = 1; o < 64; o <<= 1) { s[0] += __shfl_xor(s[0], o); s[1] += __shfl_xor(s[1], o); }
        float mean[2], q[2] = {0.f, 0.f}, rstd[2];
#pragma unroll
        for (int r = 0; r < 2; ++r) { mean[r] = s[r] * (1.0f / D);
#pragma unroll
            for (int j = 0; j < 8; ++j) { const f32x4 d = v[r][j] - mean[r]; q[r] += (d[0] * d[0] + d[1] * d[1]) + (d[2] * d[2] + d[3] * d[3]); } }
#pragma unroll
        for (int o = 1; o < 64; o <<= 1) { q[0] += __shfl_xor(q[0], o); q[1] += __shfl_xor(q[1], o); }
#pragma unroll
        for (int r = 0; r < 2; ++r) rstd[r] = 1.0f / sqrtf(q[r] * (1.0f / D) + LN_EPS);
#pragma unroll
        for (int r = 0; r < 2; ++r) { if (r && !has1) break; const int row = row0 + r * rstride; const int b = row >> 11;
#pragma unroll
            for (int j = 0; j < 8; ++j) { const int col = lane * 4 + j * 256;
                const f32x4 gg = *(const f32x4*)(lg + col), bb = *(const f32x4*)(lb + col);
                const f32x4 y = (v[r][j] - mean[r]) * rstd[r] * gg + bb;
                *(f32x4*)(xout + (size_t)row * D + col) = y;
                if (U) { const float* mp = modn + (size_t)b * 6144 + col; const f32x4 sh = *(const f32x4*)mp, sc = *(const f32x4*)(mp + 2048);
                    const f32x4 u = y * (sc + 1.0f) + sh; u32x2 w; w.x = cvt_pk_bf16(u[0], u[1]); w.y = cvt_pk_bf16(u[2], u[3]);
                    *(u32x2*)(U + (size_t)row * D + col) = w; } } }
    }
}

constexpr int N_PHASES = 2 + 6 * DEPTH;
__global__ void __launch_bounds__(NTHREADS, 2) fwd_megakernel(Args a) {
    extern __shared__ __attribute__((aligned(16))) unsigned char lds_raw[];
    LAS unsigned char* lds = (LAS unsigned char*)lds_raw;
    cg::grid_group grid = cg::this_grid();
    const int lo = a.ph_lo, hi = a.ph_hi;
#ifndef PH_MASK
#define PH_MASK 0xff
#endif
#define IN(k) (lo <= (k) && (k) < hi)
#define EN(i) ((PH_MASK >> (i)) & 1)
#ifndef PROBE_DUP
#define PROBE_DUP -1
#endif
#ifndef PROBE_SYNCS
#define PROBE_SYNCS 0
#endif
#define REPS(k) for (int rep_ = 0; rep_ < ((PROBE_DUP == (k)) ? 2 : 1); ++rep_)
    unsigned* barw = (unsigned*)(a.ws + WS_BAR);
    volatile LAS unsigned* bst = (volatile LAS unsigned*)(lds + LDS_MAIN);
    if (blockIdx.x == 0) for (int i = threadIdx.x; i < XCD_BAR_WORDS; i += NTHREADS) barw[i] = 0u;
    if (threadIdx.x == 0) { bst[0] = 0u; bst[1] = 0u; }
    __syncthreads();
    XcdBarrier xbar; xbar.bar = barw; xbar.x = 0; xbar.st = bst;
#define SEAM(k) do { if ((k) + 1 < hi) { if ((k) == 0) { grid.sync(); xbar = xcd_barrier_post(barw, bst); } else xcd_barrier(xbar); } } while (0)
    unsigned char* ws = a.ws;
    bf16_t* Hb = (bf16_t*)(ws + WS_H); float* Zb = (float*)(ws + WS_H);
    bf16_t* Ub = (bf16_t*)(ws + WS_U); bf16_t* Pb = (bf16_t*)(ws + WS_U); bf16_t* Mb = (bf16_t*)(ws + WS_U);
    bf16_t* Yb = (bf16_t*)(ws + WS_YCAT);
    const float* mod = (const float*)(ws + WS_MOD);

    REPS(0) if (EN(0) && IN(0)) {
        for (int it = blockIdx.x; it < 192; it += gridDim.x) mod_item(lds, a, it);
        weights_phase(lds, a);
        SEAM(0);
    }
    REPS(1) if (EN(1) && IN(1)) { uprep_phase(a); SEAM(1); }
    for (int i_ = 0; i_ < PROBE_SYNCS; ++i_) xcd_barrier(xbar);
    for (int l = 0; l < DEPTH; ++l) {
        const int pb = 2 + 6 * l;
        REPS(pb + 0) if (EN(2) && IN(pb + 0)) {
            Gemm g{Ub, (const bf16_t*)(ws + WS_WIN) + (size_t)l * NIN * D, D, D, D, 0};
            StaticOrder S; S.init(T, NIN, gridDim.x, blockIdx.x);
            EpiH E{Hb};
            gemm_phase<EpiH>(lds, g, S, E);
            SEAM(pb + 0);
        }
        REPS(pb + 1) if (EN(3) && IN(pb + 1)) {
            for (int it = blockIdx.x; it < 512; it += gridDim.x) attn_item(lds, Hb, Yb, a.sinks + l * 16, it);
            for (int gi = blockIdx.x * NTHREADS + threadIdx.x; gi < 131072; gi += gridDim.x * NTHREADS) pool_build(Hb, Pb, gi);
            SEAM(pb + 1);
        }
        REPS(pb + 2) if (EN(4) && IN(pb + 2)) {
            Gemm g{Pb, (const bf16_t*)(ws + WS_WGRP) + (size_t)l * 4 * 65536, 1024, 256, 256, 512};
            StaticOrder S; S.init(T, 1024, gridDim.x, blockIdx.x);
            EpiPool E{Hb, a.pool_scale + l * 1024, Yb};
            gemm_phase<EpiPool>(lds, g, S, E);
            SEAM(pb + 2);
        }
        REPS(pb + 3) if (EN(5) && IN(pb + 3)) {
            Gemm g{Yb, (const bf16_t*)(ws + WS_WCAT) + (size_t)l * D * D, D, D, D, 0};
            StaticOrder S; S.init(T, D, gridDim.x, blockIdx.x);
            EpiMerge E{Hb, Mb};
            gemm_phase<EpiMerge>(lds, g, S, E);
            SEAM(pb + 3);
        }
        REPS(pb + 4) if (EN(6) && IN(pb + 4)) {
            Gemm g{Mb, (const bf16_t*)(ws + WS_WOUT) + (size_t)l * D * D, D, D, D, 0};
            StaticOrder S; S.init(T, D, gridDim.x, blockIdx.x);
            EpiZ E{l == 0 ? a.x : a.out, mod + (size_t)l * 8 * 6144 + 4096, Zb};
            gemm_phase<EpiZ>(lds, g, S, E);
            SEAM(pb + 4);
        }
        REPS(pb + 5) if (EN(7) && IN(pb + 5)) {
            ln_phase(Zb, a.ln_g + l * D, a.ln_b + l * D, a.out, mod + (size_t)(l + 1) * 8 * 6144, (l + 1 < DEPTH) ? Ub : nullptr);
            SEAM(pb + 5);
        }
    }
#undef IN
#undef SEAM
}

extern "C" void kernel_launch(void* const* d_in, const int* in_sizes, int n_in, void* d_out, int out_size, void* d_ws, size_t ws_size, hipStream_t stream) {
    static int grid = 0;
    if (grid == 0) {
        if (n_in != 13 || in_sizes[0] != T * D || out_size != T * D || ws_size < WS_END) {
            fprintf(stderr, "kernel_launch: unexpected problem (n_in %d, in0 %d, out %d, ws %zu, need %zu); nothing launched\n", n_in, n_in > 0 ? in_sizes[0] : -1, out_size, ws_size, (size_t)WS_END);
            grid = -1; return; }
        int dev = 0, cus = 0, per_cu = 0;
        if (hipGetDevice(&dev) != hipSuccess || hipDeviceGetAttribute(&cus, hipDeviceAttributeMultiprocessorCount, dev) != hipSuccess) { grid = -1; return; }
        if (hipFuncSetAttribute((const void*)fwd_megakernel, hipFuncAttributeMaxDynamicSharedMemorySize, LDS_BYTES) != hipSuccess) { fprintf(stderr, "kernel_launch: hipFuncSetAttribute failed\n"); grid = -1; return; }
        if (hipOccupancyMaxActiveBlocksPerMultiprocessor(&per_cu, (const void*)fwd_megakernel, NTHREADS, LDS_BYTES) != hipSuccess || per_cu < 1) { fprintf(stderr, "kernel_launch: occupancy query says %d blocks per CU\n", per_cu); grid = -1; return; }
        grid = cus;
    }
    if (grid < 0) return;
    Args a{};
    a.x = (const float*)d_in[0]; a.c = (const float*)d_in[1]; a.w_ada = (const float*)d_in[2]; a.b_ada = (const float*)d_in[3]; a.w_in = (const float*)d_in[4];
    a.w_pool_grp = (const float*)d_in[5]; a.pool_scale = (const float*)d_in[6]; a.sinks = (const float*)d_in[7]; a.w_pool_up = (const float*)d_in[8];
    a.w_attn_up = (const float*)d_in[9]; a.w_out = (const float*)d_in[10]; a.ln_g = (const float*)d_in[11]; a.ln_b = (const float*)d_in[12];
    a.out = (float*)d_out; a.ws = (unsigned char*)d_ws;
    a.ph_lo = 0; a.ph_hi = N_PHASES;
    void* args[] = {&a};
    hipError_t e = hipLaunchCooperativeKernel((const void*)fwd_megakernel, dim3(grid), dim3(NTHREADS), args, LDS_BYTES, stream);
    if (e != hipSuccess) fprintf(stderr, "kernel_launch: cooperative launch failed: %s (grid %d)\n", hipGetErrorString(e), grid);
}
```
